# Optimizing an MI355X kernel written in HIP

```python
import math
import jax, jax.numpy as jnp
from jax import lax
import numpy as np

D_MODEL = 1024
BATCH = 8
SEQ = 2048
DEPTH = 1

MIX_WIDTH = D_MODEL
ATTN_WIDTH = MIX_WIDTH // 2
CONV_WIDTH = MIX_WIDTH - ATTN_WIDTH
DIFF_HEAD_DIM = 64
DIFF_V_DIM = 2 * DIFF_HEAD_DIM
N_DIFF_HEADS = ATTN_WIDTH // DIFF_V_DIM
Q_COLS = N_DIFF_HEADS * 2 * DIFF_HEAD_DIM
K_COLS = N_DIFF_HEADS * 2 * DIFF_HEAD_DIM
V_COLS = N_DIFF_HEADS * DIFF_V_DIM
CONV_IN_COLS = 2 * CONV_WIDTH
IN_COLS = Q_COLS + K_COLS + V_COLS + CONV_IN_COLS
Q_BLOCK = 128
CONV_KERNEL = 31
N_EXPERTS = 32
TOP_K = 4
D_EXPERT = D_MODEL
SWIGLU_LIMIT = 7.0
SWIGLU_ALPHA = 1.702
LN_EPS = 1e-5
DEEPNORM_ALPHA = (2.0 * DEPTH) ** 0.25
DEEPNORM_BETA = (8.0 * DEPTH) ** -0.25

kernel_name = "hymba_diffattn_conformer_moe_deepnorm"


def layer_norm(x, g, b):
    xf = x.astype(jnp.float32)
    mu = jnp.mean(xf, axis=-1, keepdims=True)
    xc = xf - mu
    var = jnp.mean(xc * xc, axis=-1, keepdims=True)
    y = xc * lax.rsqrt(var + LN_EPS) * g.astype(jnp.float32) + b.astype(jnp.float32)
    return y.astype(x.dtype)


def rms_norm(x, g):
    xf = x.astype(jnp.float32)
    y = xf * lax.rsqrt(jnp.mean(xf * xf, axis=-1, keepdims=True) + LN_EPS)
    return (y * g.astype(jnp.float32)).astype(x.dtype)


def alibi_slopes(n_heads):
    start = 2.0 ** (-8.0 / n_heads)
    return jnp.array([start ** (i + 1) for i in range(n_heads)], dtype=jnp.float32)


def diff_attention(q, k, v, lam, slopes):
    B, S, H, _, dh = q.shape
    dv = v.shape[-1]
    nb = S // Q_BLOCK
    q = q * (dh ** -0.5)
    qb = q.reshape(B, nb, Q_BLOCK, H, 2, dh).transpose(1, 0, 3, 4, 2, 5)
    kt = k.transpose(0, 2, 3, 1, 4)
    vt = v.transpose(0, 2, 1, 3)
    key_pos = jnp.arange(S, dtype=jnp.int32)

    def block(args):
        q_blk, start = args
        s = jnp.einsum('bhcqd,bhckd->bhcqk', q_blk, kt).astype(jnp.float32)
        dist = (start + jnp.arange(Q_BLOCK, dtype=jnp.int32))[:, None] - key_pos[None, :]
        bias = -slopes[:, None, None] * dist.astype(jnp.float32)
        s = jnp.where((dist >= 0)[None, None, None], s + bias[None, :, None], -jnp.inf)
        p = jax.nn.softmax(s, axis=-1)
        w = p[:, :, 0] - lam * p[:, :, 1]
        return jnp.einsum('bhqk,bhkd->bhqd', w.astype(vt.dtype), vt)

    starts = jnp.arange(nb, dtype=jnp.int32) * Q_BLOCK
    out = lax.map(block, (qb, starts))
    return out.transpose(1, 0, 3, 2, 4).reshape(B, S, H, dv)


def conformer_conv(u, conv_w, conv_b, ln_g, ln_b):
    a, g = jnp.split(u, 2, axis=-1)
    h = a * jax.nn.sigmoid(g)
    C = h.shape[-1]
    h = lax.conv_general_dilated(
        h, conv_w[:, None, :].astype(h.dtype), window_strides=(1,),
        padding=[(CONV_KERNEL - 1, 0)], dimension_numbers=('NWC', 'WIO', 'NWC'),
        feature_group_count=C) + conv_b
    h = layer_norm(h, ln_g, ln_b)
    return jax.nn.silu(h)


def clamped_swiglu(h):
    gate, up = jnp.split(h, 2, axis=-1)
    gate = jnp.minimum(gate, SWIGLU_LIMIT)
    up = jnp.clip(up, -SWIGLU_LIMIT, SWIGLU_LIMIT)
    return gate * jax.nn.sigmoid(SWIGLU_ALPHA * gate) * (up + 1.0)


def moe(x, router_w, router_b, w_gate_up, b_gate_up, w_down, b_down):
    B, S, D = x.shape
    xf = x.reshape(B * S, D)
    logits = (xf @ router_w + router_b).astype(jnp.float32)
    top_v, top_i = lax.top_k(logits, TOP_K)
    gates = jax.nn.softmax(top_v, axis=-1)
    combine = jnp.einsum('nk,nke->ne', gates, jax.nn.one_hot(top_i, N_EXPERTS, dtype=jnp.float32))
    combine = combine.astype(x.dtype)
    out = jnp.zeros_like(xf)
    for e in range(N_EXPERTS):
        h = clamped_swiglu(xf @ w_gate_up[e] + b_gate_up[e])
        out = out + combine[:, e:e + 1] * (h @ w_down[e] + b_down[e])
    return out.reshape(B, S, D)


def setup_inputs(seed: int = 0) -> dict:
    key = jax.random.key(seed)
    ks = jax.random.split(key, 24)
    L, D, E, F = DEPTH, D_MODEL, N_EXPERTS, D_EXPERT
    nrm = lambda k, shape: jax.random.normal(k, shape, dtype=jnp.float32)
    col_scale = jnp.concatenate([
        jnp.ones((Q_COLS + K_COLS,), jnp.float32),
        jnp.full((V_COLS,), DEEPNORM_BETA, jnp.float32),
        jnp.ones((CONV_IN_COLS,), jnp.float32)])
    return {
        "x": nrm(ks[0], (BATCH, SEQ, D)),
        "emb_ln_g": 1.0 + 0.02 * nrm(ks[1], (D,)),
        "emb_ln_b": 0.02 * nrm(ks[2], (D,)),
        "w_in": nrm(ks[3], (L, D, IN_COLS)) * (D ** -0.5) * col_scale,
        "lambda_q1": 0.1 * nrm(ks[4], (L, DIFF_HEAD_DIM)),
        "lambda_k1": 0.1 * nrm(ks[5], (L, DIFF_HEAD_DIM)),
        "lambda_q2": 0.1 * nrm(ks[6], (L, DIFF_HEAD_DIM)),
        "lambda_k2": 0.1 * nrm(ks[7], (L, DIFF_HEAD_DIM)),
        "subln_g": 1.0 + 0.02 * nrm(ks[8], (L, DIFF_V_DIM)),
        "conv_w": nrm(ks[9], (L, CONV_KERNEL, CONV_WIDTH)) * (CONV_KERNEL ** -0.5),
        "conv_b": 0.02 * nrm(ks[10], (L, CONV_WIDTH)),
        "conv_ln_g": 1.0 + 0.02 * nrm(ks[11], (L, CONV_WIDTH)),
        "conv_ln_b": 0.02 * nrm(ks[12], (L, CONV_WIDTH)),
        "w_out": nrm(ks[13], (L, MIX_WIDTH, D)) * (MIX_WIDTH ** -0.5) * DEEPNORM_BETA,
        "ln1_g": 1.0 + 0.02 * nrm(ks[14], (L, D)),
        "ln1_b": 0.02 * nrm(ks[15], (L, D)),
        "router_w": nrm(ks[16], (L, D, E)) * (D ** -0.5),
        "router_b": 0.01 * nrm(ks[17], (L, E)),
        "w_gate_up": nrm(ks[18], (L, E, D, 2 * F)) * (D ** -0.5) * DEEPNORM_BETA,
        "b_gate_up": 0.02 * nrm(ks[19], (L, E, 2 * F)),
        "w_down": nrm(ks[20], (L, E, F, D)) * (F ** -0.5) * DEEPNORM_BETA,
        "b_down": 0.02 * nrm(ks[21], (L, E, D)),
        "ln2_g": 1.0 + 0.02 * nrm(ks[22], (L, D)),
        "ln2_b": 0.02 * nrm(ks[23], (L, D)),
    }


def reference(x, emb_ln_g, emb_ln_b, w_in, lambda_q1, lambda_k1, lambda_q2, lambda_k2,
              subln_g, conv_w, conv_b, conv_ln_g, conv_ln_b, w_out, ln1_g, ln1_b,
              router_w, router_b, w_gate_up, b_gate_up, w_down, b_down, ln2_g, ln2_b):
    B, S, D = x.shape
    slopes = alibi_slopes(N_DIFF_HEADS)
    x = layer_norm(x, emb_ln_g, emb_ln_b)
    for i in range(DEPTH):
        lambda_init = 0.8 - 0.6 * math.exp(-0.3 * i)
        h = x @ w_in[i]
        q = h[..., :Q_COLS].reshape(B, S, N_DIFF_HEADS, 2, DIFF_HEAD_DIM)
        k = h[..., Q_COLS:Q_COLS + K_COLS].reshape(B, S, N_DIFF_HEADS, 2, DIFF_HEAD_DIM)
        v = h[..., Q_COLS + K_COLS:Q_COLS + K_COLS + V_COLS].reshape(B, S, N_DIFF_HEADS, DIFF_V_DIM)
        u = h[..., Q_COLS + K_COLS + V_COLS:]
        lam = (jnp.exp(jnp.sum(lambda_q1[i].astype(jnp.float32) * lambda_k1[i].astype(jnp.float32)))
               - jnp.exp(jnp.sum(lambda_q2[i].astype(jnp.float32) * lambda_k2[i].astype(jnp.float32)))
               + lambda_init)
        a = diff_attention(q, k, v, lam, slopes)
        a = (rms_norm(a, subln_g[i]) * (1.0 - lambda_init)).reshape(B, S, ATTN_WIDTH)
        c = conformer_conv(u, conv_w[i], conv_b[i], conv_ln_g[i], conv_ln_b[i])
        mix = jnp.concatenate([a, c], axis=-1) @ w_out[i]
        x = layer_norm(DEEPNORM_ALPHA * x + mix, ln1_g[i], ln1_b[i])
        y = moe(x, router_w[i], router_b[i], w_gate_up[i], b_gate_up[i], w_down[i], b_down[i])
        x = layer_norm(DEEPNORM_ALPHA * x + y, ln2_g[i], ln2_b[i])
    return x
```

```cpp
#include <hip/hip_runtime.h>
#include <cstdio>
#include <cstdint>

#ifndef MK_N_LAUNCHES
#define MK_N_LAUNCHES 1
#endif

#define GAS __attribute__((address_space(1)))
#define LAS __attribute__((address_space(3)))
typedef unsigned short bf16;
typedef short bf16x8 __attribute__((ext_vector_type(8)));
typedef short s16x4 __attribute__((ext_vector_type(4)));
typedef float f32x2 __attribute__((ext_vector_type(2)));
typedef float f32x4 __attribute__((ext_vector_type(4)));
typedef float f32x16 __attribute__((ext_vector_type(16)));
typedef unsigned u32x2 __attribute__((ext_vector_type(2)));
typedef unsigned u32x4 __attribute__((ext_vector_type(4)));
typedef GAS unsigned gu32;
#define RLX_AGENT __ATOMIC_RELAXED, __HIP_MEMORY_SCOPE_AGENT
#define LDS_WAIT() asm volatile("s_waitcnt lgkmcnt(0)" ::: "memory")
#define VM_WAIT() asm volatile("s_waitcnt vmcnt(0)" ::: "memory")

constexpr int NTOK = 16384, DM = 1024, SEQ = 2048;
constexpr int IN_COLS = 2560, AW = 512;
constexpr int NEXP = 32, TOPK = 4, DFF = 1024, NPAIR = NTOK * TOPK;
constexpr int LISTCAP = NTOK;
constexpr int HIDROWS = NPAIR + NEXP * 256;
constexpr float LN_EPS = 1e-5f;
constexpr float ALPHA = 1.189207115002721f;
constexpr float LOG2E = 1.4426950408889634f;
constexpr float QSCALE = 0.125f * LOG2E;
constexpr float LAMBDA_INIT = 0.2f;
constexpr int NWAVES = 8;

constexpr size_t MiB = 1u << 20;
constexpr size_t WS_CTL = 0, CTL_ZERO_BYTES = 1 * MiB;
constexpr size_t WS_WIN = 2 * MiB;
constexpr size_t WS_WOUT = 8 * MiB;
constexpr size_t WS_WGU = 16 * MiB;
constexpr size_t WS_WD = 144 * MiB;
constexpr size_t WS_XN = 208 * MiB;
constexpr size_t WS_Q = 240 * MiB, WS_K = 256 * MiB, WS_V = 272 * MiB, WS_HG = 288 * MiB;
constexpr size_t WS_AC = 304 * MiB;
constexpr size_t WS_Y1 = 336 * MiB;
constexpr size_t WS_X1 = 400 * MiB;
constexpr size_t WS_HID = 432 * MiB;
constexpr size_t WS_YP = 576 * MiB;
constexpr size_t WS_LIST = 704 * MiB;
constexpr size_t WS_GATE = 706 * MiB;
constexpr size_t WS_END = 708 * MiB;
constexpr int CW_TMO = 0;
constexpr int CW_BAR = 4096;
constexpr int CW_GCNT = 8192;

constexpr int RING_OFF = 0, RING_BYTES = 131072;
constexpr int LDSCTL_OFF = RING_BYTES, MISC_OFF = LDSCTL_OFF + 320;
constexpr int MOE_TP_OFF = LDSCTL_OFF + 1024;
constexpr int LDS_BYTES = 147456;

__device__ __forceinline__ unsigned cvt_pk_bf16(float lo, float hi) { unsigned r; asm volatile("v_cvt_pk_bf16_f32 %0, %1, %2" : "=v"(r) : "v"(lo), "v"(hi)); return r; }
__device__ __forceinline__ float bf_lo(unsigned w) { return __uint_as_float(w << 16); }
__device__ __forceinline__ float bf_hi(unsigned w) { return __uint_as_float(w & 0xffff0000u); }
__device__ __forceinline__ float fast_exp2(float x) { return __builtin_amdgcn_exp2f(x); }
__device__ __forceinline__ float fast_rcp(float x) { return __builtin_amdgcn_rcpf(x); }
__device__ __forceinline__ float sigmoidf_(float x) { return fast_rcp(1.0f + fast_exp2(-LOG2E * x)); }
__device__ __forceinline__ float wave_sum(float v) {
#pragma unroll
    for (int o = 1; o < 64; o <<= 1) v += __shfl_xor(v, o);
    return v;
}

namespace pg8 {
constexpr int BM = 256, BK = 64, HALF = 128, HTB = HALF * BK * 2, STAGE_BYTES = 8 * HTB, NXCD = 8, WGM = 8, KD = 1024;
__host__ __device__ __forceinline__ int lds_byte(int r, int c) { const int st = (r >> 4) * 2 + (c >> 5), rr = r & 15, cc = c & 31, ob = rr * 64 + cc * 2; return st * 1024 + (ob ^ (((ob >> 9) & 1) << 5)); }
__host__ __device__ __forceinline__ void stage_rc(int b, int& R, int& C) { const int st = b / 1024, sb = b % 1024, swz = sb ^ (((sb >> 9) & 1) << 5); R = (st >> 1) * 16 + swz / 64; C = (st & 1) * 32 + (swz % 64) / 2; }
__host__ __device__ __forceinline__ int perm32(int rho) { const int n = rho >> 4, i = rho & 15; return 8 * (i >> 2) + 4 * n + (i & 3); }

struct Unit { int pm, pn, e, mtl, cnt; };

struct DenseOrder {
    int nM, nN, nwg, G, c; const char* Bt;
    __device__ __forceinline__ void init(int M, int N, int G_, int c_, const void* Bt_) { nM = M / BM; nN = N / BM; nwg = nM * nN; G = G_; c = c_; Bt = (const char*)Bt_; }
    __device__ __forceinline__ bool next(int i, Unit& u) const {
        const long L = (long)i * G + c; if (L >= nwg) return false;
        int wgid = (int)L; { const int q = nwg / NXCD, r = nwg % NXCD, xcd = wgid % NXCD, off = wgid / NXCD; wgid = (xcd < r ? xcd * (q + 1) : r * (q + 1) + (xcd - r) * q) + off; }
        const int nig = WGM * nN, gid = wgid / nig, fm = gid * WGM, gsz = (nM - fm) < WGM ? (nM - fm) : WGM;
        u.pm = fm + ((wgid % nig) % gsz); u.pn = (wgid % nig) / gsz; u.e = 0; u.mtl = 0; u.cnt = 0; return true;
    }
    __device__ __forceinline__ unsigned arow_off(const Unit& u, int rl) const { return (unsigned)(u.pm * BM + rl) * (unsigned)(KD * 2); }
    __device__ __forceinline__ const char* bbase(const Unit& u) const { return Bt + (size_t)u.pn * (size_t)(BM * KD * 2); }
};
template <int NPN, bool GATHER> struct MoeOrder {
    const LAS int* tp; const LAS int* cn; int G, vcu, lane; const int* list; const char* Bt; size_t bstride;
    __device__ __forceinline__ bool next(int i, Unit& u) const {
        const int L = i * G + vcu, chunk = L >> 5, s = L & 31;
        const int mt = (NPN == 8) ? chunk * 4 + (s & 3) : chunk * 8 + (s & 7), pn = (NPN == 8) ? (s >> 2) : (s >> 3);
        const int MT = tp[32];
        if (mt >= MT) return false;
        const int lj = lane < 1 ? 1 : (lane > 32 ? 32 : lane);
        const unsigned long long bm = __ballot(lane >= 1 && lane <= 32 && tp[lj] <= mt);
        const int e = __builtin_amdgcn_readfirstlane(__popcll(bm));
        u.pm = mt; u.pn = pn; u.e = e; u.mtl = __builtin_amdgcn_readfirstlane(mt - tp[e]); u.cnt = __builtin_amdgcn_readfirstlane(cn[e]); return true;
    }
    __device__ __forceinline__ unsigned arow_off(const Unit& u, int rl) const {
        if (GATHER) { int pos = u.mtl * BM + rl; pos = pos < u.cnt ? pos : u.cnt - 1; const int p = list[u.e * LISTCAP + pos]; return (unsigned)(p >> 2) * (unsigned)(KD * 2); }
        else return (unsigned)(u.pm * BM + rl) * (unsigned)(KD * 2);
    }
    __device__ __forceinline__ const char* bbase(const Unit& u) const { return Bt + (size_t)u.e * bstride + (size_t)u.pn * (size_t)(BM * KD * 2); }
};

template <class Epi, class Sched>
__device__ __forceinline__ void gemm_phase(LAS unsigned char* lds, const char* Abase, const Sched& S, const Epi& E) {
    const int tid = threadIdx.x, wid = __builtin_amdgcn_readfirstlane(tid >> 6), lane = tid & 63, wr = wid >> 2, wc = wid & 3, fr = lane & 15, fq = lane >> 4;
    constexpr int K = KD, nt = K / BK;
    int RA[2]; unsigned CA2[2], voffB[2];
#pragma unroll
    for (int i = 0; i < 2; ++i) { int R, C; stage_rc(tid * 16 + i * 8192, R, C); const int Rb = Epi::PERM ? ((R & ~31) + perm32(R & 31)) : R;
        RA[i] = R; CA2[i] = (unsigned)C * 2u; voffB[i] = (unsigned)(Rb * K + C) * 2u; }
    constexpr size_t kstep = (size_t)(BK * 2);
    constexpr size_t hstep = (size_t)HALF * K * 2;
    const unsigned ldsw = (unsigned)wid * 1024u;
    const int aoff = lds_byte(wr * 64 + fr, fq * 8), boff = lds_byte(wc * 32 + fr, fq * 8);
#define PG8_SA(b, h) (((b) * 2 + (h)) * HTB)
#define PG8_SB(b, h) ((4 + (b) * 2 + (h)) * HTB)
#define PG8_STAGE_B(bufoff, gbase) do { _Pragma("unroll") for (int _i = 0; _i < 2; ++_i) \
        __builtin_amdgcn_global_load_lds((const unsigned*)((const char*)(gbase) + voffB[_i]), (LAS unsigned*)(lds + (bufoff) + ldsw + _i * 8192), 16, 0, 0); } while (0)
#define PG8_STAGE_A(bufoff, offs, kb) do { _Pragma("unroll") for (int _i = 0; _i < 2; ++_i) \
        __builtin_amdgcn_global_load_lds((const unsigned*)(Abase + (size_t)(offs)[_i] + (size_t)(kb)), (LAS unsigned*)(lds + (bufoff) + ldsw + _i * 8192), 16, 0, 0); } while (0)
#define PG8_LDA(dst, b, h) do { _Pragma("unroll") for (int m = 0; m < 4; ++m) _Pragma("unroll") for (int k = 0; k < 2; ++k) dst[m][k] = *(const LAS bf16x8*)(lds + PG8_SA(b, h) + aoff + m * 2048 + k * 1024); } while (0)
#define PG8_LDB(dst, b, h) do { _Pragma("unroll") for (int n = 0; n < 2; ++n) _Pragma("unroll") for (int k = 0; k < 2; ++k) dst[n][k] = *(const LAS bf16x8*)(lds + PG8_SB(b, h) + boff + n * 2048 + k * 1024); } while (0)
#define PG8_MMA(ai, bj, At, Bt) do { __builtin_amdgcn_s_setprio(1); _Pragma("unroll") for (int m = 0; m < 4; ++m) _Pragma("unroll") for (int n = 0; n < 2; ++n) _Pragma("unroll") for (int k = 0; k < 2; ++k) \
        acc[ai][bj][m][n] = __builtin_amdgcn_mfma_f32_16x16x32_bf16(Bt[n][k], At[m][k], acc[ai][bj][m][n], 0, 0, 0); __builtin_amdgcn_s_setprio(0); } while (0)
#define PG8_WAIT_V(n) asm volatile("s_waitcnt vmcnt(" #n ")" ::: "memory")
#define PG8_WAIT_L(n) asm volatile("s_waitcnt lgkmcnt(" #n ")" ::: "memory")
#define PG8_BAR __builtin_amdgcn_s_barrier()
#define PG8_SCHED __builtin_amdgcn_sched_barrier(0)
    Unit cur, nxt; int ui = 0;
    if (!S.next(0, cur)) return;
    f32x4 acc[2][2][4][2];
#pragma unroll
    for (int a = 0; a < 2; ++a)
#pragma unroll
        for (int b = 0; b < 2; ++b)
#pragma unroll
            for (int m = 0; m < 4; ++m)
#pragma unroll
                for (int n = 0; n < 2; ++n) acc[a][b][m][n] = (f32x4){0.f, 0.f, 0.f, 0.f};
    bf16x8 At[4][2], B0[2][2], B1[2][2];
    unsigned ao[2][2], no[2][2];
#pragma unroll
    for (int h = 0; h < 2; ++h)
#pragma unroll
        for (int i = 0; i < 2; ++i) ao[h][i] = S.arow_off(cur, h * HALF + RA[i]) + CA2[i];
    const char* cB = S.bbase(cur);
    PG8_STAGE_B(PG8_SB(0, 0), cB); PG8_STAGE_B(PG8_SB(0, 1), cB + hstep); PG8_STAGE_A(PG8_SA(0, 0), ao[0], 0); PG8_STAGE_A(PG8_SA(0, 1), ao[1], 0);
    if (wr == 1) PG8_BAR;
    PG8_WAIT_V(2); PG8_BAR;
    PG8_STAGE_B(PG8_SB(1, 0), cB + kstep); PG8_STAGE_A(PG8_SA(1, 0), ao[0], kstep); PG8_STAGE_B(PG8_SB(1, 1), cB + hstep + kstep);
    PG8_WAIT_V(6); PG8_BAR;
    for (;;) {
        const bool has_next = S.next(ui + 1, nxt);
        const char* nB = cB;
        if (has_next) {
#pragma unroll
            for (int h = 0; h < 2; ++h)
#pragma unroll
                for (int i = 0; i < 2; ++i) no[h][i] = S.arow_off(nxt, h * HALF + RA[i]) + CA2[i];
            nB = S.bbase(nxt);
        } else {
#pragma unroll
            for (int h = 0; h < 2; ++h)
#pragma unroll
                for (int i = 0; i < 2; ++i) no[h][i] = ao[h][i];
        }
        for (int t = 0; t < nt; t += 2) {
            const bool last = (t == nt - 2);
            const size_t kb1 = (size_t)(t + 1) * kstep;
            unsigned s2[2][2];
#pragma unroll
            for (int h = 0; h < 2; ++h)
#pragma unroll
                for (int i = 0; i < 2; ++i) s2[h][i] = last ? no[h][i] : ao[h][i];
            const size_t kb2 = last ? 0 : (size_t)(t + 2) * kstep, kb3 = kb2 + kstep;
            const char* b2 = last ? nB : cB + (size_t)(t + 2) * kstep; const char* b3 = b2 + kstep;
            PG8_LDB(B0, 0, 0); PG8_LDB(B1, 0, 1); PG8_SCHED; PG8_LDA(At, 0, 0); PG8_STAGE_A(PG8_SA(1, 1), ao[1], kb1);
            PG8_WAIT_V(8); PG8_WAIT_L(0); PG8_BAR; PG8_MMA(0, 0, At, B0); PG8_MMA(0, 1, At, B1); PG8_BAR; PG8_SCHED;
            PG8_LDA(At, 0, 1); PG8_STAGE_B(PG8_SB(0, 0), b2); PG8_STAGE_B(PG8_SB(0, 1), b2 + hstep); PG8_STAGE_A(PG8_SA(0, 0), s2[0], kb2);
            PG8_WAIT_V(8); PG8_WAIT_L(0); PG8_BAR; PG8_MMA(1, 0, At, B0); PG8_MMA(1, 1, At, B1); PG8_BAR; PG8_SCHED;
            PG8_LDB(B0, 1, 0); PG8_LDB(B1, 1, 1); PG8_SCHED; PG8_LDA(At, 1, 0); PG8_STAGE_A(PG8_SA(0, 1), s2[1], kb2);
            PG8_WAIT_V(8); PG8_WAIT_L(0); PG8_BAR; PG8_MMA(0, 0, At, B0); PG8_MMA(0, 1, At, B1); PG8_BAR; PG8_SCHED;
            PG8_LDA(At, 1, 1); PG8_STAGE_B(PG8_SB(1, 0), b3); PG8_STAGE_B(PG8_SB(1, 1), b3 + hstep); PG8_STAGE_A(PG8_SA(1, 0), s2[0], kb3);
            PG8_WAIT_V(8); PG8_WAIT_L(0); PG8_BAR; PG8_MMA(1, 0, At, B0); PG8_MMA(1, 1, At, B1); PG8_BAR; PG8_SCHED;
        }
        if (wr == 0) PG8_BAR;
        E(acc, cur, wr, wc, fr, fq);
        if (!has_next) break;
#pragma unroll
        for (int a = 0; a < 2; ++a)
#pragma unroll
            for (int b = 0; b < 2; ++b)
#pragma unroll
                for (int m = 0; m < 4; ++m)
#pragma unroll
                    for (int n = 0; n < 2; ++n) acc[a][b][m][n] = (f32x4){0.f, 0.f, 0.f, 0.f};
        cur = nxt; cB = nB; ++ui;
#pragma unroll
        for (int h = 0; h < 2; ++h)
#pragma unroll
            for (int i = 0; i < 2; ++i) ao[h][i] = no[h][i];
        if (wr == 1) PG8_BAR;
    }
    PG8_WAIT_V(0);
    PG8_BAR;
#undef PG8_SA
#undef PG8_SB
#undef PG8_STAGE_A
#undef PG8_STAGE_B
#undef PG8_LDA
#undef PG8_LDB
#undef PG8_MMA
#undef PG8_WAIT_V
#undef PG8_WAIT_L
#undef PG8_BAR
#undef PG8_SCHED
}

struct EpiIn {
    static constexpr bool PERM = true;
    bf16* Q; size_t qkv_stride;
    __device__ __forceinline__ void operator()(const f32x4 (&acc)[2][2][4][2], const Unit& u, int wr, int wc, int fr, int fq) const {
        const int row0 = u.pm * BM + wr * 64 + fr; bf16* HG = Q + 3 * qkv_stride;
        if (u.pn < 6) {
            bf16* base = Q + (size_t)(u.pn >> 1) * qkv_stride; const float sc = u.pn < 2 ? QSCALE : 1.0f;
            const int col0 = (u.pn & 1) * 256 + wc * 32 + 8 * fq;
#pragma unroll
            for (int ai = 0; ai < 2; ++ai)
#pragma unroll
                for (int m = 0; m < 4; ++m) { bf16* rowp = base + (size_t)(row0 + ai * HALF + m * 16) * AW + col0;
#pragma unroll
                    for (int bj = 0; bj < 2; ++bj) { const f32x4 v0 = acc[ai][bj][m][0] * sc, v1 = acc[ai][bj][m][1] * sc;
                        u32x4 w; w.x = cvt_pk_bf16(v0[0], v0[1]); w.y = cvt_pk_bf16(v0[2], v0[3]); w.z = cvt_pk_bf16(v1[0], v1[1]); w.w = cvt_pk_bf16(v1[2], v1[3]);
                        *(u32x4*)(rowp + bj * HALF) = w; } }
        } else {
            const int col0 = (u.pn - 6) * 128 + wc * 32 + 8 * fq;
#pragma unroll
            for (int ai = 0; ai < 2; ++ai)
#pragma unroll
                for (int m = 0; m < 4; ++m) { bf16* rowp = HG + (size_t)(row0 + ai * HALF + m * 16) * AW + col0;
                    float o[8];
#pragma unroll
                    for (int n = 0; n < 2; ++n)
#pragma unroll
                        for (int j = 0; j < 4; ++j) o[n * 4 + j] = acc[ai][0][m][n][j] * sigmoidf_(acc[ai][1][m][n][j]);
                    u32x4 w; w.x = cvt_pk_bf16(o[0], o[1]); w.y = cvt_pk_bf16(o[2], o[3]); w.z = cvt_pk_bf16(o[4], o[5]); w.w = cvt_pk_bf16(o[6], o[7]);
                    *(u32x4*)rowp = w; }
        }
    }
};
struct EpiOut {
    static constexpr bool PERM = false;
    float* Y1; const bf16* XN;
    __device__ __forceinline__ void operator()(const f32x4 (&acc)[2][2][4][2], const Unit& u, int wr, int wc, int fr, int fq) const {
        const int row0 = u.pm * BM + wr * 64 + fr, col0 = u.pn * BM + wc * 32 + 4 * fq;
#pragma unroll
        for (int ai = 0; ai < 2; ++ai)
#pragma unroll
            for (int m = 0; m < 4; ++m) { const size_t ro = (size_t)(row0 + ai * HALF + m * 16) * DM + col0;
#pragma unroll
                for (int bj = 0; bj < 2; ++bj)
#pragma unroll
                    for (int n = 0; n < 2; ++n) { const u32x2 xw = *(const u32x2*)(XN + ro + bj * HALF + n * 16);
                        f32x4 o = acc[ai][bj][m][n]; o[0] += ALPHA * bf_lo(xw.x); o[1] += ALPHA * bf_hi(xw.x); o[2] += ALPHA * bf_lo(xw.y); o[3] += ALPHA * bf_hi(xw.y);
                        *(f32x4*)(Y1 + ro + bj * HALF + n * 16) = o; } }
    }
};
struct EpiSwiglu {
    static constexpr bool PERM = true;
    bf16* HID; const float* bgu;
    __device__ __forceinline__ void operator()(const f32x4 (&acc)[2][2][4][2], const Unit& u, int wr, int wc, int fr, int fq) const {
        const int row0 = u.pm * BM + wr * 64 + fr, ch0 = u.pn * 128 + wc * 32 + 8 * fq;
        const float* bg = bgu + (size_t)u.e * 2048 + ch0; const float* bu = bg + 1024;
        f32x4 bgv[2], buv[2];
#pragma unroll
        for (int n = 0; n < 2; ++n) { bgv[n] = *(const f32x4*)(bg + 4 * n); buv[n] = *(const f32x4*)(bu + 4 * n); }
#pragma unroll
        for (int ai = 0; ai < 2; ++ai)
#pragma unroll
            for (int m = 0; m < 4; ++m) { bf16* rowp = HID + (size_t)(row0 + ai * HALF + m * 16) * DFF + ch0;
                float o[8];
#pragma unroll
                for (int n = 0; n < 2; ++n)
#pragma unroll
                    for (int j = 0; j < 4; ++j) { float g = acc[ai][0][m][n][j] + bgv[n][j], up = acc[ai][1][m][n][j] + buv[n][j];
                        g = fminf(g, 7.0f); up = fminf(fmaxf(up, -7.0f), 7.0f);
                        o[n * 4 + j] = g * sigmoidf_(1.702f * g) * (up + 1.0f); }
                u32x4 w; w.x = cvt_pk_bf16(o[0], o[1]); w.y = cvt_pk_bf16(o[2], o[3]); w.z = cvt_pk_bf16(o[4], o[5]); w.w = cvt_pk_bf16(o[6], o[7]);
                *(u32x4*)rowp = w; }
    }
};
struct EpiDown {
    static constexpr bool PERM = true;
    bf16* YP; const float* bd; const int* list; const float* gatew;
    __device__ __forceinline__ void operator()(const f32x4 (&acc)[2][2][4][2], const Unit& u, int wr, int wc, int fr, int fq) const {
        const int rl0 = wr * 64 + fr, col0 = u.pn * BM + wc * 32 + 8 * fq;
        f32x4 bv[2][2];
#pragma unroll
        for (int bj = 0; bj < 2; ++bj)
#pragma unroll
            for (int n = 0; n < 2; ++n) bv[bj][n] = *(const f32x4*)(bd + (size_t)u.e * DM + col0 + bj * HALF + 4 * n);
#pragma unroll
        for (int ai = 0; ai < 2; ++ai)
#pragma unroll
            for (int m = 0; m < 4; ++m) { const int pos = u.mtl * BM + rl0 + ai * HALF + m * 16;
                if (pos < u.cnt) { const int p = list[u.e * LISTCAP + pos]; const float gw = gatew[p]; bf16* rowp = YP + (size_t)p * DM + col0;
#pragma unroll
                    for (int bj = 0; bj < 2; ++bj) { const f32x4 v0 = (acc[ai][bj][m][0] + bv[bj][0]) * gw, v1 = (acc[ai][bj][m][1] + bv[bj][1]) * gw;
                        u32x4 w; w.x = cvt_pk_bf16(v0[0], v0[1]); w.y = cvt_pk_bf16(v0[2], v0[3]); w.z = cvt_pk_bf16(v1[0], v1[1]); w.w = cvt_pk_bf16(v1[2], v1[3]);
                        *(u32x4*)(rowp + bj * HALF) = w; } } }
    }
};
}

#define XB_TMO      128
#define XB_XCNT(j)  (256  + 64 * (j))
#define XB_XSUB(j)  (1280 + 64 * (j))
#define XB_XGEN(j)  (2304 + 64 * (j))
#define XB_TOP      3328
#define XB_TOPGEN   3392
#define XCD_BAR_WORDS 3456
#define XB_SPIN_CAP (1u << 18)
__device__ __forceinline__ unsigned xb_ld(unsigned* p)              { return __hip_atomic_load(p, __ATOMIC_RELAXED, __HIP_MEMORY_SCOPE_AGENT); }
__device__ __forceinline__ unsigned xb_add(unsigned* p, unsigned v) { return __hip_atomic_fetch_add(p, v, __ATOMIC_RELAXED, __HIP_MEMORY_SCOPE_AGENT); }
__device__ __forceinline__ unsigned xb_xcc_id() { return (unsigned)__builtin_amdgcn_s_getreg((3 << 11) | 20) & 0xFu; }
#define XB_SPIN(cond, bar) do { unsigned _sp = 0; while (cond) { __builtin_amdgcn_s_sleep(1); \
    if ((++_sp & 255u) == 0u) { if (xb_ld(&(bar)[XB_TMO])) break; if (_sp > XB_SPIN_CAP) { atomicAdd(&(bar)[XB_TMO], 1u); break; } } } } while (0)
struct XcdBarrier { unsigned* bar; unsigned x; volatile LAS unsigned* st; };
__device__ __forceinline__ XcdBarrier xcd_barrier_post(unsigned* bar, volatile LAS unsigned* st) {
    XcdBarrier b; b.bar = bar; b.x = xb_xcc_id(); b.st = st;
    if (threadIdx.x == 0) (void)xb_add(&bar[XB_XCNT(b.x)], 1u);
    return b;
}
__device__ __forceinline__ void xcd_barrier_complete(unsigned* bar, unsigned x, unsigned& nloc, unsigned& nx) {
    const unsigned G = gridDim.x * gridDim.y * gridDim.z;
    unsigned sum, cnt, mine, sp = 0u;
    for (;;) {
        sum = 0u; cnt = 0u; mine = 0u;
#pragma unroll
        for (unsigned j = 0; j < 16; ++j) { const unsigned c = xb_ld(&bar[XB_XCNT(j)]); sum += c; cnt += (c > 0u) ? 1u : 0u; mine = (j == x) ? c : mine; }
        if (sum == G) break;
        __builtin_amdgcn_s_sleep(1);
        if ((++sp & 255u) == 0u) { if (xb_ld(&bar[XB_TMO])) break; if (sp > XB_SPIN_CAP) { atomicAdd(&bar[XB_TMO], 1u); break; } }
    }
    nloc = mine > 0u ? mine : 1u; nx = cnt > 0u ? cnt : 1u;
}
__device__ __forceinline__ void xcd_barrier(const XcdBarrier& b) {
    asm volatile("s_waitcnt vmcnt(0)" ::: "memory");
    __syncthreads();
    if (threadIdx.x == 0) {
        unsigned* bar = b.bar;
        __builtin_amdgcn_s_waitcnt(0);
        unsigned nloc = b.st[0], nx = b.st[1];
        if (nloc == 0u) { xcd_barrier_complete(bar, b.x, nloc, nx); b.st[0] = nloc; b.st[1] = nx; }
        const unsigned old = xb_add(&bar[XB_XSUB(b.x)], 1u);
        const unsigned gen = old / nloc;
        if (old + 1u == (gen + 1u) * nloc) {
            __builtin_amdgcn_fence(__ATOMIC_RELEASE, "agent");
            asm volatile("s_waitcnt vmcnt(0)" ::: "memory");
            const unsigned og = xb_add(&bar[XB_TOP], 1u);
            const unsigned tg = og / nx;
            if (og + 1u == (tg + 1u) * nx) xb_add(&bar[XB_TOPGEN], 1u);
            else XB_SPIN(xb_ld(&bar[XB_TOPGEN]) == tg, bar);
            __builtin_amdgcn_fence(__ATOMIC_ACQUIRE, "agent");
            xb_add(&bar[XB_XGEN(b.x)], 1u);
            asm volatile("s_waitcnt vmcnt(0)" ::: "memory");
        } else {
            XB_SPIN(xb_ld(&bar[XB_XGEN(b.x)]) == gen, bar);
            __builtin_amdgcn_fence(__ATOMIC_ACQUIRE, "agent");
            asm volatile("s_waitcnt vmcnt(0)" ::: "memory");
        }
    }
    __syncthreads();
}

struct Frame {
    LAS unsigned char* lds; volatile LAS unsigned* MISC; gu32* ctl;
    int tid, lane, wave, vcu, G;
};
struct Args { const float* in[24]; float* out; unsigned char* ws; int ph_lo, ph_hi; };

__device__ __forceinline__ void p0_transpose_item(const float* W, int K, int N, bf16* WT, int k0, int n0, int drow0, LAS float* scr, int lane) {
#pragma unroll 8
    for (int i = 0; i < 32; ++i) { const int kk = 2 * i + (lane >> 5); scr[kk * 33 + (lane & 31)] = W[(size_t)(k0 + kk) * N + n0 + (lane & 31)]; }
    LDS_WAIT(); asm volatile("" ::: "memory");
    const int c = lane & 7;
#pragma unroll
    for (int j = 0; j < 4; ++j) { const int n = (lane >> 3) + 8 * j; const LAS float* s = scr + (8 * c) * 33 + n;
        u32x4 o; o.x = cvt_pk_bf16(s[0 * 33], s[1 * 33]); o.y = cvt_pk_bf16(s[2 * 33], s[3 * 33]); o.z = cvt_pk_bf16(s[4 * 33], s[5 * 33]); o.w = cvt_pk_bf16(s[6 * 33], s[7 * 33]);
        *(GAS u32x4*)(WT + (size_t)(drow0 + n) * K + k0 + 8 * c) = o; }
    LDS_WAIT(); asm volatile("" ::: "memory");
}
__device__ __forceinline__ void ln_row_to_bf16(const float* xrow, const float* g, const float* b, bf16* orow, int lane) {
    const GAS f32x4* xr = (const GAS f32x4*)xrow + lane;
    f32x4 v[4]; float s = 0.f;
#pragma unroll
    for (int j = 0; j < 4; ++j) { v[j] = xr[64 * j]; s += (v[j].x + v[j].y) + (v[j].z + v[j].w); }
    const float mean = wave_sum(s) * (1.f / DM); float s2 = 0.f;
#pragma unroll
    for (int j = 0; j < 4; ++j) { v[j] = v[j] - mean; s2 += (v[j].x * v[j].x + v[j].y * v[j].y) + (v[j].z * v[j].z + v[j].w * v[j].w); }
    const float rstd = 1.f / sqrtf(wave_sum(s2) * (1.f / DM) + LN_EPS);
    GAS u32x2* o8 = (GAS u32x2*)orow + lane;
#pragma unroll
    for (int j = 0; j < 4; ++j) { const f32x4 gg = *((const GAS f32x4*)g + lane + 64 * j), bb = *((const GAS f32x4*)b + lane + 64 * j);
        const f32x4 y = v[j] * rstd * gg + bb; u32x2 w; w.x = cvt_pk_bf16(y.x, y.y); w.y = cvt_pk_bf16(y.z, y.w); o8[64 * j] = w; }
}

namespace att {
constexpr int STG = 32768;
constexpr int LDS_Q = 2 * STG;
constexpr int LDS_WS = LDSCTL_OFF + 2048;
__device__ __forceinline__ int crow(int r, int hi) { return (r & 3) + 8 * (r >> 2) + 4 * hi; }
__device__ __forceinline__ float swapmax(float m) { auto rr = __builtin_amdgcn_permlane32_swap(__float_as_uint(m), __float_as_uint(m), false, false); return fmaxf(__uint_as_float(rr[0]), __uint_as_float(rr[1])); }
__device__ __forceinline__ float swapsum(float m) { auto rr = __builtin_amdgcn_permlane32_swap(__float_as_uint(m), __float_as_uint(m), false, false); return __uint_as_float(rr[0]) + __uint_as_float(rr[1]); }
__device__ __forceinline__ s16x4 vtr(const LAS unsigned char* p) { typedef short v4i16_t __attribute__((ext_vector_type(4))); return __builtin_bit_cast(s16x4, __builtin_amdgcn_ds_read_tr16_b64_v4i16((LAS v4i16_t*)p)); }
}

__global__ void __launch_bounds__(NWAVES * 64, 2) hymba_fwd(Args args) {
    extern __shared__ __attribute__((aligned(16))) unsigned char lds_raw[];
    Frame F;
    F.lds = (LAS unsigned char*)lds_raw;
    F.MISC = (volatile LAS unsigned*)(F.lds + MISC_OFF);
    F.tid = threadIdx.x; F.lane = F.tid & 63; F.wave = __builtin_amdgcn_readfirstlane(F.tid >> 6);
    F.G = gridDim.x; { const int bx = blockIdx.x; F.vcu = (F.G % 8 == 0) ? (bx % 8) * (F.G / 8) + bx / 8 : bx; }
    unsigned char* ws = args.ws;
    F.ctl = (gu32*)(ws + WS_CTL);
    for (int u = F.tid; u < (LDS_BYTES - LDSCTL_OFF) / 4; u += NWAVES * 64) ((LAS unsigned*)(F.lds + LDSCTL_OFF))[u] = 0u;
    __syncthreads();
    XcdBarrier bar; bar.bar = (unsigned*)(F.ctl + CW_BAR); bar.x = 0; bar.st = nullptr;
    if (MK_N_LAUNCHES == 1) bar = xcd_barrier_post((unsigned*)(F.ctl + CW_BAR), F.MISC + 8);
    const int lo = args.ph_lo, hi = args.ph_hi;
#ifndef PH_MASK
#define PH_MASK 0xff
#endif
#define IN(k) (((PH_MASK >> (k)) & 1) && lo <= (k) && (k) < hi)
#define BOTH(k) (IN(k) && IN((k) + 1))
#define GRID_BAR() do { xcd_barrier(bar); } while (0)
    const int lane = F.lane, wave = F.wave, tid = F.tid;
    const int gw = F.vcu * NWAVES + wave, NGW = F.G * NWAVES;

    const float* x_in = args.in[0];
    bf16* Win_t = (bf16*)(ws + WS_WIN); bf16* Wout_t = (bf16*)(ws + WS_WOUT); bf16* Wgu_t = (bf16*)(ws + WS_WGU); bf16* Wd_t = (bf16*)(ws + WS_WD);
    bf16* XN = (bf16*)(ws + WS_XN); bf16* Qb = (bf16*)(ws + WS_Q); bf16* Kb = (bf16*)(ws + WS_K); bf16* Vb = (bf16*)(ws + WS_V); bf16* HG = (bf16*)(ws + WS_HG);
    bf16* AC = (bf16*)(ws + WS_AC); float* Y1 = (float*)(ws + WS_Y1); bf16* X1 = (bf16*)(ws + WS_X1); bf16* HID = (bf16*)(ws + WS_HID); bf16* YP = (bf16*)(ws + WS_YP);
    int* LIST = (int*)(ws + WS_LIST); float* GATEW = (float*)(ws + WS_GATE);

    if (IN(0)) {
        LAS float* scr = (LAS float*)(F.lds + RING_OFF + wave * 16384);
        constexpr int I_IN = 16 * (IN_COLS / 32), I_OUT = 16 * 32, I_GU = 16 * 64, I_D = 16 * 32;
        constexpr int NITEMS = I_IN + I_OUT + NEXP * I_GU + NEXP * I_D;
        for (int it = gw; it < NITEMS; it += NGW) {
            int r = it;
            if (r < I_IN) { const int nblk = IN_COLS / 32, kb = r / nblk, nb = r % nblk, n0 = 32 * nb; int d;
                if (n0 < 1536) d = n0; else { const int j = n0 - 1536, g = j >= 512, ch = j & 511; d = 1536 + (ch >> 7) * 256 + g * 128 + (ch & 127); }
                p0_transpose_item(args.in[3], DM, IN_COLS, Win_t, 64 * kb, n0, d, scr, lane); continue; }
            r -= I_IN;
            if (r < I_OUT) { const int kb = r / 32, nb = r % 32; p0_transpose_item(args.in[13], DM, DM, Wout_t, 64 * kb, 32 * nb, 32 * nb, scr, lane); continue; }
            r -= I_OUT;
            if (r < NEXP * I_GU) { const int e = r / I_GU, q = r % I_GU, kb = q / 64, nb = q % 64, n0 = 32 * nb, g = n0 >= 1024, ch = n0 & 1023, d = (ch >> 7) * 256 + g * 128 + (ch & 127);
                p0_transpose_item(args.in[18] + (size_t)e * DM * 2048, DM, 2048, Wgu_t + (size_t)e * 2048 * DM, 64 * kb, n0, d, scr, lane); continue; }
            r -= NEXP * I_GU;
            { const int e = r / I_D, q = r % I_D, kb = q / 32, nb = q % 32;
                p0_transpose_item(args.in[20] + (size_t)e * DFF * DM, DFF, DM, Wd_t + (size_t)e * DM * DFF, 64 * kb, 32 * nb, 32 * nb, scr, lane); }
        }
        for (int m = gw; m < NTOK; m += NGW) ln_row_to_bf16(x_in + (size_t)m * DM, args.in[1], args.in[2], XN + (size_t)m * DM, lane);
        if (BOTH(0)) GRID_BAR();
    }

    if (IN(1)) {
        pg8::DenseOrder S; S.init(NTOK, IN_COLS, F.G, (int)blockIdx.x, Win_t);
        static_assert(WS_K - WS_Q == WS_V - WS_K && WS_HG - WS_V == WS_K - WS_Q, "Q|K|V|HG equally spaced");
        pg8::EpiIn E{Qb, (size_t)(WS_K - WS_Q) / 2};
        pg8::gemm_phase<pg8::EpiIn, pg8::DenseOrder>(F.lds + RING_OFF, (const char*)XN, S, E);
        if (BOTH(1)) GRID_BAR();
    }

    if (IN(2)) {
        using namespace att;
#ifndef NO_ATTN
        for (int unit = F.vcu; unit < 256; unit += F.G) {
            const int bh = unit >> 3, c = unit & 7, b = bh >> 2, h = bh & 3;
            const int r32 = lane & 31, hi = lane >> 5;
            int p;
            switch (wave) { case 0: p = c; break; case 4: p = 63 - c; break; case 1: p = 15 - c; break; case 5: p = 48 + c; break;
                            case 2: p = 16 + c; break; case 6: p = 47 - c; break; case 3: p = 31 - c; break; default: p = 32 + c; break; }
            const int dt = p >> 1;
            const int T = ((63 - c) >> 1) + 1;
            const size_t rowbase = (size_t)b * SEQ;
            const int q = 32 * p + r32;
            const float sl2 = LOG2E * (h == 0 ? 0.25f : h == 1 ? 0.0625f : h == 2 ? 0.015625f : 0.00390625f);
            LAS unsigned char* ql = F.lds + RING_OFF + LDS_Q + wave * 8192 + lane * 16;
#pragma unroll
            for (int cp = 0; cp < 2; ++cp)
#pragma unroll
                for (int d0 = 0; d0 < 4; ++d0) *(LAS bf16x8*)(ql + (cp * 4 + d0) * 1024) = *(const bf16x8*)(Qb + (rowbase + 32 * p + r32) * AW + h * 128 + cp * 64 + d0 * 16 + hi * 8);
            f32x16 o[2][4];
#pragma unroll
            for (int cp = 0; cp < 2; ++cp)
#pragma unroll
                for (int db = 0; db < 4; ++db)
#pragma unroll
                    for (int r = 0; r < 16; ++r) o[cp][db][r] = 0.f;
            float mrun[2] = {-INFINITY, -INFINITY}, lrun[2] = {0.f, 0.f};
            LAS float* wsf = (LAS float*)(F.lds + LDS_WS) + wave * 128;
            unsigned ksrc[2], vsrc[2];
#pragma unroll
            for (int i = 0; i < 2; ++i) { const int pc = 2 * wave + i; ksrc[i] = (unsigned)((rowbase + lane) * AW + h * 128 + pc * 8);
                vsrc[i] = (unsigned)((rowbase + (pc & 3) * 16 + (lane >> 2)) * AW + h * 128 + (pc >> 2) * 32 + (lane & 3) * 8); }
#define ATT_ISSUE(t, st) do { _Pragma("unroll") for (int _i = 0; _i < 2; ++_i) { \
                __builtin_amdgcn_global_load_lds((const unsigned*)(Kb + ksrc[_i] + (size_t)(t) * 64 * AW), (LAS unsigned*)(F.lds + RING_OFF + (st) * STG + (2 * wave + _i) * 1024), 16, 0, 0); \
                __builtin_amdgcn_global_load_lds((const unsigned*)(Vb + vsrc[_i] + (size_t)(t) * 64 * AW), (LAS unsigned*)(F.lds + RING_OFF + (st) * STG + 16384 + (2 * wave + _i) * 1024), 16, 0, 0); } } while (0)
            ATT_ISSUE(T - 1, 0);
            int st = 0;
            const int vlane = ((lane >> 4) & 1) * 32 + (lane & 3) * 8 + (4 * hi + ((lane & 15) >> 2)) * 64;
            for (int it = 0; it < T; ++it) {
                const int t = T - 1 - it;
                if (it + 1 < T) ATT_ISSUE(t - 1, st ^ 1);
                if (it + 1 < T) asm volatile("s_waitcnt vmcnt(4)" ::: "memory"); else asm volatile("s_waitcnt vmcnt(0)" ::: "memory");
                __builtin_amdgcn_s_barrier();
                asm volatile("" ::: "memory");
                float sl2v = sl2; asm volatile("" : "+v"(sl2v));
                if (t <= dt) {
                    const LAS unsigned char* Ks = F.lds + RING_OFF + st * STG;
                    const LAS unsigned char* Vs = Ks + 16384;
                    const float fb = sl2v * (float)(64 * t + 4 * hi - q);
#pragma unroll
                    for (int cp = 0; cp < 2; ++cp) {
                        f32x16 p0, p1;
#pragma unroll
                        for (int r = 0; r < 16; ++r) { p0[r] = fb + sl2v * (float)((r & 3) + 8 * (r >> 2)); p1[r] = p0[r] + 32.0f * sl2v; }
#pragma unroll
                        for (int d0 = 0; d0 < 4; ++d0) {
                            const LAS unsigned char* kb = Ks + (cp * 8 + 2 * d0 + hi) * 1024 + r32 * 16;
                            const bf16x8 k0 = *(const LAS bf16x8*)kb, k1 = *(const LAS bf16x8*)(kb + 512);
                            const bf16x8 qf = *(const LAS bf16x8*)(ql + (cp * 4 + d0) * 1024);
                            p0 = __builtin_amdgcn_mfma_f32_32x32x16_bf16(k0, qf, p0, 0, 0, 0);
                            p1 = __builtin_amdgcn_mfma_f32_32x32x16_bf16(k1, qf, p1, 0, 0, 0);
                        }
                        if (t == dt) {
                            const int kb0 = 64 * t + 4 * hi - q;
#pragma unroll
                            for (int r = 0; r < 16; ++r) { const int rel = kb0 + (r & 3) + 8 * (r >> 2); if (rel > 0) p0[r] = -INFINITY; if (rel + 32 > 0) p1[r] = -INFINITY; }
                        }
                        float rm = fmaxf(p0[0], p1[0]);
#pragma unroll
                        for (int r = 1; r < 16; ++r) rm = fmaxf(rm, fmaxf(p0[r], p1[r]));
                        rm = swapmax(rm);
                        const float mn = fmaxf(mrun[cp], rm);
                        if (__any(mn > mrun[cp])) {
                            const float f = fast_exp2(mrun[cp] - mn);
                            lrun[cp] *= f; mrun[cp] = mn;
                            if (hi == 0) wsf[r32] = f;
                            LDS_WAIT();
#pragma unroll
                            for (int r = 0; r < 16; ++r) { const float fr_ = wsf[crow(r, hi)];
#pragma unroll
                                for (int db = 0; db < 4; ++db) o[cp][db][r] *= fr_; }
                            LDS_WAIT();
                        }
                        float ls = 0.f;
#pragma unroll
                        for (int r = 0; r < 16; ++r) { p0[r] = fast_exp2(p0[r] - mrun[cp]); p1[r] = fast_exp2(p1[r] - mrun[cp]); ls += p0[r] + p1[r]; }
                        lrun[cp] += ls;
                        bf16x8 pa[4];
                        { u32x4 w0, w1, w2, w3;
                        w0.x = cvt_pk_bf16(p0[0], p0[1]); w0.y = cvt_pk_bf16(p0[2], p0[3]); w0.z = cvt_pk_bf16(p0[4], p0[5]); w0.w = cvt_pk_bf16(p0[6], p0[7]);
                        w1.x = cvt_pk_bf16(p0[8], p0[9]); w1.y = cvt_pk_bf16(p0[10], p0[11]); w1.z = cvt_pk_bf16(p0[12], p0[13]); w1.w = cvt_pk_bf16(p0[14], p0[15]);
                        w2.x = cvt_pk_bf16(p1[0], p1[1]); w2.y = cvt_pk_bf16(p1[2], p1[3]); w2.z = cvt_pk_bf16(p1[4], p1[5]); w2.w = cvt_pk_bf16(p1[6], p1[7]);
                        w3.x = cvt_pk_bf16(p1[8], p1[9]); w3.y = cvt_pk_bf16(p1[10], p1[11]); w3.z = cvt_pk_bf16(p1[12], p1[13]); w3.w = cvt_pk_bf16(p1[14], p1[15]);
                        pa[0] = __builtin_bit_cast(bf16x8, w0); pa[1] = __builtin_bit_cast(bf16x8, w1); pa[2] = __builtin_bit_cast(bf16x8, w2); pa[3] = __builtin_bit_cast(bf16x8, w3); }
#pragma unroll
                        for (int db = 0; db < 4; ++db) {
                            __builtin_amdgcn_sched_barrier(0);
#pragma unroll
                            for (int ks = 0; ks < 4; ++ks) {
                                const LAS unsigned char* vp = Vs + (db * 4 + ks) * 1024 + vlane;
                                const s16x4 vl = vtr(vp), vh = vtr(vp + 512);
                                const bf16x8 vf = (bf16x8){vl[0], vl[1], vl[2], vl[3], vh[0], vh[1], vh[2], vh[3]};
                                o[cp][db] = __builtin_amdgcn_mfma_f32_32x32x16_bf16(pa[ks], vf, o[cp][db], 0, 0, 0);
                            }
                        }
                        __builtin_amdgcn_sched_barrier(0);
                    }
                }
                asm volatile("s_waitcnt lgkmcnt(0)" ::: "memory"); __builtin_amdgcn_s_barrier(); asm volatile("" ::: "memory");
                st ^= 1;
            }
#undef ATT_ISSUE
            {
                int lane_o = lane; asm volatile("" : "+v"(lane_o));
                const int r32 = lane_o & 31, hi = lane_o >> 5;
                float lam;
                { const float a = args.in[4][lane_o] * args.in[5][lane_o], bb2 = args.in[6][lane_o] * args.in[7][lane_o];
                  lam = __expf(wave_sum(a)) - __expf(wave_sum(bb2)) + LAMBDA_INIT; }
                LAS float* wsf = (LAS float*)(F.lds + LDS_WS) + wave * 128;
                const float l0 = swapsum(lrun[0]), l1 = swapsum(lrun[1]);
                if (hi == 0) { wsf[r32] = fast_rcp(l0); wsf[32 + r32] = lam * fast_rcp(l1); }
                LDS_WAIT();
                float gsub[4];
#pragma unroll
                for (int db = 0; db < 4; ++db) gsub[db] = args.in[8][db * 32 + r32] * (1.0f - LAMBDA_INIT);
#pragma unroll
                for (int r = 0; r < 16; ++r) {
                    const int qq = crow(r, hi); const float a0 = wsf[qq], a1 = wsf[32 + qq];
                    float v[4], ss = 0.f;
#pragma unroll
                    for (int db = 0; db < 4; ++db) { v[db] = o[0][db][r] * a0 - o[1][db][r] * a1; ss += v[db] * v[db]; }
                    ss += __shfl_xor(ss, 1); ss += __shfl_xor(ss, 2); ss += __shfl_xor(ss, 4); ss += __shfl_xor(ss, 8); ss += __shfl_xor(ss, 16);
                    const float rs = 1.0f / sqrtf(ss * (1.0f / 128.0f) + LN_EPS);
                    bf16* op = AC + (rowbase + 32 * p + qq) * DM + h * 128 + r32;
#pragma unroll
                    for (int db = 0; db < 4; ++db) op[db * 32] = (bf16)(cvt_pk_bf16(v[db] * rs * gsub[db], 0.f) & 0xffffu);
                }
                LDS_WAIT();
            }
            asm volatile("s_waitcnt lgkmcnt(0)" ::: "memory"); __builtin_amdgcn_s_barrier(); asm volatile("" ::: "memory");
        }
#endif
#ifndef NO_CONV
        {
            LAS float* WP = (LAS float*)(F.lds + RING_OFF);
            for (int idx = tid; idx < 45 * 512; idx += NWAVES * 64) { const int jj = idx >> 9, ch = idx & 511, j = jj - 7; WP[idx] = (j >= 0 && j <= 30) ? args.in[9][j * 512 + ch] : 0.f; }
            __syncthreads();
            const int ch0 = lane * 8;
            for (int item = gw; item < NTOK / 8; item += NGW) {
                const int t0 = item * 8, tpos = t0 & (SEQ - 1);
                float acc[8][8];
                { const f32x4 b0 = *(const f32x4*)(args.in[10] + ch0), b1 = *(const f32x4*)(args.in[10] + ch0 + 4);
#pragma unroll
                  for (int tt = 0; tt < 8; ++tt) { acc[tt][0] = b0[0]; acc[tt][1] = b0[1]; acc[tt][2] = b0[2]; acc[tt][3] = b0[3]; acc[tt][4] = b1[0]; acc[tt][5] = b1[1]; acc[tt][6] = b1[2]; acc[tt][7] = b1[3]; } }
                for (int i = 0; i < 38; ++i) {
                    if (tpos - 30 + i < 0) continue;
                    const u32x4 hw = *(const u32x4*)(HG + (size_t)(t0 - 30 + i) * AW + ch0);
                    float hv[8]; hv[0] = bf_lo(hw.x); hv[1] = bf_hi(hw.x); hv[2] = bf_lo(hw.y); hv[3] = bf_hi(hw.y); hv[4] = bf_lo(hw.z); hv[5] = bf_hi(hw.z); hv[6] = bf_lo(hw.w); hv[7] = bf_hi(hw.w);
                    const LAS float* wr_ = WP + i * 512 + ch0;
#pragma unroll
                    for (int tt = 0; tt < 8; ++tt) { const f32x4 w0 = *(const LAS f32x4*)(wr_ + (7 - tt) * 512), w1 = *(const LAS f32x4*)(wr_ + (7 - tt) * 512 + 4);
                        acc[tt][0] += w0[0] * hv[0]; acc[tt][1] += w0[1] * hv[1]; acc[tt][2] += w0[2] * hv[2]; acc[tt][3] += w0[3] * hv[3];
                        acc[tt][4] += w1[0] * hv[4]; acc[tt][5] += w1[1] * hv[5]; acc[tt][6] += w1[2] * hv[6]; acc[tt][7] += w1[3] * hv[7]; }
                }
                const f32x4 g0 = *(const f32x4*)(args.in[11] + ch0), g1 = *(const f32x4*)(args.in[11] + ch0 + 4), c0 = *(const f32x4*)(args.in[12] + ch0), c1 = *(const f32x4*)(args.in[12] + ch0 + 4);
#pragma unroll
                for (int tt = 0; tt < 8; ++tt) {
                    float s = 0.f;
#pragma unroll
                    for (int k = 0; k < 8; ++k) s += acc[tt][k];
                    const float mean = wave_sum(s) * (1.0f / 512.0f); float s2 = 0.f;
#pragma unroll
                    for (int k = 0; k < 8; ++k) { acc[tt][k] -= mean; s2 += acc[tt][k] * acc[tt][k]; }
                    const float rstd = 1.0f / sqrtf(wave_sum(s2) * (1.0f / 512.0f) + LN_EPS);
                    float y[8];
#pragma unroll
                    for (int k = 0; k < 8; ++k) { const float gg = k < 4 ? g0[k & 3] : g1[k & 3], cc = k < 4 ? c0[k & 3] : c1[k & 3]; const float v = acc[tt][k] * rstd * gg + cc; y[k] = v * sigmoidf_(v); }
                    u32x4 w; w.x = cvt_pk_bf16(y[0], y[1]); w.y = cvt_pk_bf16(y[2], y[3]); w.z = cvt_pk_bf16(y[4], y[5]); w.w = cvt_pk_bf16(y[6], y[7]);
                    *(u32x4*)(AC + (size_t)(t0 + tt) * DM + 512 + ch0) = w;
                }
            }
            __syncthreads();
        }
#endif
        if (BOTH(2)) GRID_BAR();
    }

    if (IN(3)) {
        pg8::DenseOrder S; S.init(NTOK, DM, F.G, (int)blockIdx.x, Wout_t);
        pg8::EpiOut E{Y1, XN};
        pg8::gemm_phase<pg8::EpiOut, pg8::DenseOrder>(F.lds + RING_OFF, (const char*)AC, S, E);
        if (BOTH(3)) GRID_BAR();
    }

    if (IN(4)) {
        constexpr int XSTR = 1028;
        LAS float* XS = (LAS float*)(F.lds + RING_OFF);
        LAS float* PL = (LAS float*)(F.lds + RING_OFF + 65792);
        LAS float* LG = (LAS float*)(F.lds + RING_OFF + 82176);
        LAS int* SEL = (LAS int*)(F.lds + RING_OFF + 84224);
        LAS float* GT = (LAS float*)(F.lds + RING_OFF + 85248);
        LAS int* RK = (LAS int*)(F.lds + RING_OFF + 86272);
        LAS int* LCNT = (LAS int*)(F.lds + RING_OFF + 87296);
        LAS int* GBASE = (LAS int*)(F.lds + RING_OFF + 87424);
        if (tid < 32) LCNT[tid] = 0;
        float rwf[32][2];
#pragma unroll
        for (int s = 0; s < 32; ++s) { const int k = 128 * wave + 4 * s + (lane >> 4); rwf[s][0] = args.in[16][k * 32 + (lane & 15)]; rwf[s][1] = args.in[16][k * 32 + 16 + (lane & 15)]; }
        __syncthreads();
        int gi = 0;
        for (int g = blockIdx.x; g < NTOK / 16; g += F.G, ++gi) {
#pragma unroll
            for (int rr = 0; rr < 2; ++rr) {
                const int lr = 2 * wave + rr; const size_t row = (size_t)g * 16 + lr;
                const GAS f32x4* xr = (const GAS f32x4*)(Y1 + row * DM) + lane;
                f32x4 v[4]; float s = 0.f;
#pragma unroll
                for (int j = 0; j < 4; ++j) { v[j] = xr[64 * j]; s += (v[j].x + v[j].y) + (v[j].z + v[j].w); }
                const float mean = wave_sum(s) * (1.f / DM); float s2 = 0.f;
#pragma unroll
                for (int j = 0; j < 4; ++j) { v[j] = v[j] - mean; s2 += (v[j].x * v[j].x + v[j].y * v[j].y) + (v[j].z * v[j].z + v[j].w * v[j].w); }
                const float rstd = 1.f / sqrtf(wave_sum(s2) * (1.f / DM) + LN_EPS);
                GAS u32x2* o8 = (GAS u32x2*)(X1 + row * DM) + lane;
#pragma unroll
                for (int j = 0; j < 4; ++j) { const f32x4 gg = *((const GAS f32x4*)args.in[14] + lane + 64 * j), bb = *((const GAS f32x4*)args.in[15] + lane + 64 * j);
                    const f32x4 y = v[j] * rstd * gg + bb; u32x2 w; w.x = cvt_pk_bf16(y.x, y.y); w.y = cvt_pk_bf16(y.z, y.w); o8[64 * j] = w;
                    *(LAS f32x4*)(XS + lr * XSTR + 4 * lane + 256 * j) = y; }
            }
            __syncthreads();
            {
                f32x4 a0 = (f32x4){0.f, 0.f, 0.f, 0.f}, a1 = a0;
                const LAS float* xp = XS + (lane & 15) * XSTR + 128 * wave + (lane >> 4);
#pragma unroll
                for (int s = 0; s < 32; ++s) { const float a = xp[4 * s];
                    a0 = __builtin_amdgcn_mfma_f32_16x16x4f32(a, rwf[s][0], a0, 0, 0, 0);
                    a1 = __builtin_amdgcn_mfma_f32_16x16x4f32(a, rwf[s][1], a1, 0, 0, 0); }
#pragma unroll
                for (int r = 0; r < 4; ++r) { PL[(wave * 16 + 4 * (lane >> 4) + r) * 32 + (lane & 15)] = a0[r]; PL[(wave * 16 + 4 * (lane >> 4) + r) * 32 + 16 + (lane & 15)] = a1[r]; }
            }
            __syncthreads();
            { const int row = tid >> 5, e = tid & 31; float s = args.in[17][e];
#pragma unroll
              for (int w = 0; w < 8; ++w) s += PL[(w * 16 + row) * 32 + e];
              LG[row * 32 + e] = s; }
            __syncthreads();
            if (tid < 16) {
                float lv[32];
#pragma unroll
                for (int e = 0; e < 32; ++e) lv[e] = LG[tid * 32 + e];
                int se[4]; float sv[4];
#pragma unroll
                for (int k = 0; k < 4; ++k) { float best = -INFINITY; int bi = 0;
#pragma unroll
                    for (int e = 0; e < 32; ++e) { const bool take = lv[e] > best; best = take ? lv[e] : best; bi = take ? e : bi; }
                    se[k] = bi; sv[k] = best;
#pragma unroll
                    for (int e = 0; e < 32; ++e) lv[e] = (e == bi) ? -INFINITY : lv[e]; }
                float ex[4], es = 0.f;
#pragma unroll
                for (int k = 0; k < 4; ++k) { ex[k] = __expf(sv[k] - sv[0]); es += ex[k]; }
                const float inv = 1.0f / es; const int lrow = gi * 16 + tid;
#pragma unroll
                for (int k = 0; k < 4; ++k) { SEL[lrow * 4 + k] = se[k]; GT[lrow * 4 + k] = ex[k] * inv; RK[lrow * 4 + k] = atomicAdd((int*)&LCNT[se[k]], 1); }
            }
        }
        __syncthreads();
        if (tid < 32) GBASE[tid] = (int)__hip_atomic_fetch_add(F.ctl + CW_GCNT + 64 * tid, (unsigned)LCNT[tid], RLX_AGENT);
        __syncthreads();
        if (tid < 256) {
            const int lrow = tid >> 2, k = tid & 3, gidx = lrow >> 4;
            if (gidx < gi) { const int g = blockIdx.x + gidx * F.G, token = g * 16 + (lrow & 15), p = token * 4 + k, e = SEL[lrow * 4 + k];
                LIST[e * LISTCAP + GBASE[e] + RK[lrow * 4 + k]] = p; GATEW[p] = GT[lrow * 4 + k]; }
        }
        __syncthreads();
        if (BOTH(4)) GRID_BAR();
    }

    if (IN(5) || IN(6)) {
        LAS int* TP = (LAS int*)(F.lds + MOE_TP_OFF); LAS int* CN = TP + 64;
        if (tid < 32) CN[tid] = (int)__hip_atomic_load(F.ctl + CW_GCNT + 64 * tid, RLX_AGENT);
        __syncthreads();
        if (tid == 0) { int a = 0; for (int e = 0; e < 32; ++e) { TP[e] = a; a += (CN[e] + 255) >> 8; } TP[32] = a; }
        __syncthreads();
    }
    if (IN(5)) {
        pg8::MoeOrder<8, true> S{(const LAS int*)(F.lds + MOE_TP_OFF), (const LAS int*)(F.lds + MOE_TP_OFF) + 64, F.G, F.vcu, lane, LIST, (const char*)Wgu_t, (size_t)2048 * DM * 2};
        pg8::EpiSwiglu E{HID, args.in[19]};
        pg8::gemm_phase<pg8::EpiSwiglu, pg8::MoeOrder<8, true>>(F.lds + RING_OFF, (const char*)X1, S, E);
        if (BOTH(5)) GRID_BAR();
    }
    if (IN(6)) {
        pg8::MoeOrder<4, false> S{(const LAS int*)(F.lds + MOE_TP_OFF), (const LAS int*)(F.lds + MOE_TP_OFF) + 64, F.G, F.vcu, lane, LIST, (const char*)Wd_t, (size_t)DM * DFF * 2};
        pg8::EpiDown E{YP, args.in[21], LIST, GATEW};
        pg8::gemm_phase<pg8::EpiDown, pg8::MoeOrder<4, false>>(F.lds + RING_OFF, (const char*)HID, S, E);
        if (BOTH(6)) GRID_BAR();
    }
    if (IN(7)) {
        const unsigned bad = (MK_N_LAUNCHES == 1) ? __hip_atomic_load((gu32*)(F.ctl + CW_BAR + XB_TMO), RLX_AGENT) : 0u;
        for (int row = gw; row < NTOK; row += NGW) {
            float v[16];
#pragma unroll
            for (int j = 0; j < 2; ++j) { const u32x4 xw = *(const u32x4*)(X1 + (size_t)row * DM + 8 * lane + 512 * j);
                v[8 * j + 0] = ALPHA * bf_lo(xw.x); v[8 * j + 1] = ALPHA * bf_hi(xw.x); v[8 * j + 2] = ALPHA * bf_lo(xw.y); v[8 * j + 3] = ALPHA * bf_hi(xw.y);
                v[8 * j + 4] = ALPHA * bf_lo(xw.z); v[8 * j + 5] = ALPHA * bf_hi(xw.z); v[8 * j + 6] = ALPHA * bf_lo(xw.w); v[8 * j + 7] = ALPHA * bf_hi(xw.w); }
#pragma unroll
            for (int k = 0; k < 4; ++k)
#pragma unroll
                for (int j = 0; j < 2; ++j) { const u32x4 yw = *(const u32x4*)(YP + ((size_t)row * 4 + k) * DM + 8 * lane + 512 * j);
                    v[8 * j + 0] += bf_lo(yw.x); v[8 * j + 1] += bf_hi(yw.x); v[8 * j + 2] += bf_lo(yw.y); v[8 * j + 3] += bf_hi(yw.y);
                    v[8 * j + 4] += bf_lo(yw.z); v[8 * j + 5] += bf_hi(yw.z); v[8 * j + 6] += bf_lo(yw.w); v[8 * j + 7] += bf_hi(yw.w); }
            float s = 0.f;
#pragma unroll
            for (int i = 0; i < 16; ++i) s += v[i];
            const float mean = wave_sum(s) * (1.f / DM); float s2 = 0.f;
#pragma unroll
            for (int i = 0; i < 16; ++i) { v[i] -= mean; s2 += v[i] * v[i]; }
            const float rstd = 1.f / sqrtf(wave_sum(s2) * (1.f / DM) + LN_EPS);
#pragma unroll
            for (int j = 0; j < 2; ++j)
#pragma unroll
                for (int hh = 0; hh < 2; ++hh) { const int c0 = 8 * lane + 512 * j + 4 * hh;
                    const f32x4 gg = *(const f32x4*)(args.in[22] + c0), bb = *(const f32x4*)(args.in[23] + c0);
                    f32x4 o; o[0] = v[8 * j + 4 * hh + 0] * rstd * gg[0] + bb[0]; o[1] = v[8 * j + 4 * hh + 1] * rstd * gg[1] + bb[1]; o[2] = v[8 * j + 4 * hh + 2] * rstd * gg[2] + bb[2]; o[3] = v[8 * j + 4 * hh + 3] * rstd * gg[3] + bb[3];
                    if (bad) { const float qn = __builtin_nanf(""); o = (f32x4){qn, qn, qn, qn}; }
                    *(f32x4*)(args.out + (size_t)row * DM + c0) = o; }
        }
    }
#undef IN
#undef BOTH
#undef GRID_BAR
}

extern "C" void kernel_launch(void* const* d_in, const int* in_sizes, int n_in, void* d_out, int out_size, void* d_ws, size_t ws_size, hipStream_t stream) {
    static int grid = 0;
    if (grid == 0) {
        if (n_in != 24 || in_sizes[0] != NTOK * DM || out_size != NTOK * DM || ws_size < WS_END) { fprintf(stderr, "kernel_launch: unexpected shapes (n_in %d, in0 %d, out %d, ws %zu); nothing launched\n", n_in, n_in > 0 ? in_sizes[0] : -1, out_size, ws_size); grid = -1; return; }
        int dev = 0, cus = 0, per_cu = 0;
        if (hipGetDevice(&dev) != hipSuccess || hipDeviceGetAttribute(&cus, hipDeviceAttributeMultiprocessorCount, dev) != hipSuccess) { grid = -1; return; }
        if (hipFuncSetAttribute((const void*)hymba_fwd, hipFuncAttributeMaxDynamicSharedMemorySize, LDS_BYTES) != hipSuccess) { fprintf(stderr, "kernel_launch: hipFuncSetAttribute failed\n"); grid = -1; return; }
        if (hipOccupancyMaxActiveBlocksPerMultiprocessor(&per_cu, (const void*)hymba_fwd, NWAVES * 64, LDS_BYTES) != hipSuccess || per_cu < 1)
            fprintf(stderr, "kernel_launch: note: occupancy query reports %d workgroups per CU\n", per_cu);
        (void)hipGetLastError();
        grid = cus;
        if (grid != 256) fprintf(stderr, "kernel_launch: %d CUs; this kernel is laid out for 256\n", grid);
    }
    if (grid < 0) return;
    (void)hipMemsetAsync((char*)d_ws + WS_CTL, 0, CTL_ZERO_BYTES, stream);
    Args a{};
    for (int i = 0; i < 24; ++i) a.in[i] = (const float*)d_in[i];
    a.out = (float*)d_out; a.ws = (unsigned char*)d_ws;
    if (MK_N_LAUNCHES == 1) { a.ph_lo = 0; a.ph_hi = 8; hipLaunchKernelGGL(hymba_fwd, dim3(grid), dim3(NWAVES * 64), LDS_BYTES, stream, a); }
    else for (int li = 0; li < 8; ++li) { a.ph_lo = li; a.ph_hi = li + 1; hipLaunchKernelGGL(hymba_fwd, dim3(grid), dim3(NWAVES * 64), LDS_BYTES, stream, a); }
}
```

```cpp
#include <hip/hip_runtime.h>
#include <cstdio>
#include <cstdint>

#ifndef MK_N_LAUNCHES
#define MK_N_LAUNCHES 1
#endif

#define GAS __attribute__((address_space(1)))
#define LAS __attribute__((address_space(3)))
typedef unsigned short bf16;
typedef short bf16x8 __attribute__((ext_vector_type(8)));
typedef short s16x4 __attribute__((ext_vector_type(4)));
typedef float f32x2 __attribute__((ext_vector_type(2)));
typedef float f32x4 __attribute__((ext_vector_type(4)));
typedef float f32x16 __attribute__((ext_vector_type(16)));
typedef unsigned u32x2 __attribute__((ext_vector_type(2)));
typedef unsigned u32x4 __attribute__((ext_vector_type(4)));
typedef GAS unsigned gu32;
#define RLX_AGENT __ATOMIC_RELAXED, __HIP_MEMORY_SCOPE_AGENT
#define LDS_WAIT() asm volatile("s_waitcnt lgkmcnt(0)" ::: "memory")
#define VM_WAIT() asm volatile("s_waitcnt vmcnt(0)" ::: "memory")

constexpr int NTOK = 16384, DM = 1024, SEQ = 2048;
constexpr int IN_COLS = 2560, AW = 512;
constexpr int NEXP = 32, TOPK = 4, DFF = 1024, NPAIR = NTOK * TOPK;
constexpr int LISTCAP = NTOK;
constexpr int HIDROWS = NPAIR + NEXP * 256;
constexpr float LN_EPS = 1e-5f;
constexpr float ALPHA = 1.189207115002721f;
constexpr float LOG2E = 1.4426950408889634f;
constexpr float QSCALE = 0.125f * LOG2E;
constexpr float LAMBDA_INIT = 0.2f;
constexpr int NWAVES = 8;
constexpr float SX8 = 4.0f, SW8 = 64.0f, SH8 = 4.0f;

constexpr size_t MiB = 1u << 20;
constexpr size_t WS_CTL = 0, CTL_ZERO_BYTES = 1 * MiB;
constexpr size_t WS_WIN = 2 * MiB;
constexpr size_t WS_WOUT = 8 * MiB;
constexpr size_t WS_WGU = 16 * MiB;
constexpr size_t WS_WD = 144 * MiB;
constexpr size_t WS_XN = 208 * MiB;
constexpr size_t WS_Q = 240 * MiB, WS_K = 256 * MiB, WS_V = 272 * MiB, WS_HG = 288 * MiB;
constexpr size_t WS_AC = 304 * MiB;
constexpr size_t WS_Y1 = 336 * MiB;
constexpr size_t WS_X1 = 400 * MiB;
constexpr size_t WS_HID = 432 * MiB;
constexpr size_t WS_YP = 576 * MiB;
constexpr size_t WS_LIST = 704 * MiB;
constexpr size_t WS_GATE = 706 * MiB;
constexpr size_t WS_X1Q = 708 * MiB;
constexpr size_t WS_END = 724 * MiB;
constexpr int CW_TMO = 0;
constexpr int CW_BAR = 4096;
constexpr int CW_GCNT = 8192;

constexpr int RING_OFF = 0, RING_BYTES = 131072;
constexpr int LDSCTL_OFF = RING_BYTES, MISC_OFF = LDSCTL_OFF + 320;
constexpr int MOE_TP_OFF = LDSCTL_OFF + 1024;
constexpr int LDS_BYTES = 147456;

__device__ __forceinline__ unsigned cvt_pk_bf16(float lo, float hi) { unsigned r; asm volatile("v_cvt_pk_bf16_f32 %0, %1, %2" : "=v"(r) : "v"(lo), "v"(hi)); return r; }
__device__ __forceinline__ unsigned pk4_fp8(float a, float b, float c, float d) { int w = 0; w = __builtin_amdgcn_cvt_pk_fp8_f32(a, b, w, false); w = __builtin_amdgcn_cvt_pk_fp8_f32(c, d, w, true); return (unsigned)w; }
__device__ __forceinline__ float bf_lo(unsigned w) { return __uint_as_float(w << 16); }
__device__ __forceinline__ float bf_hi(unsigned w) { return __uint_as_float(w & 0xffff0000u); }
__device__ __forceinline__ float fast_exp2(float x) { return __builtin_amdgcn_exp2f(x); }
__device__ __forceinline__ float fast_rcp(float x) { return __builtin_amdgcn_rcpf(x); }
__device__ __forceinline__ float sigmoidf_(float x) { return fast_rcp(1.0f + fast_exp2(-LOG2E * x)); }
__device__ __forceinline__ float wave_sum(float v) {
#pragma unroll
    for (int o = 1; o < 64; o <<= 1) v += __shfl_xor(v, o);
    return v;
}

namespace pg8 {
constexpr int BM = 256, BK = 64, HALF = 128, HTB = HALF * BK * 2, STAGE_BYTES = 8 * HTB, NXCD = 8, WGM = 8, KD = 1024;
__host__ __device__ __forceinline__ int lds_byte(int r, int c) { const int st = (r >> 4) * 2 + (c >> 5), rr = r & 15, cc = c & 31, ob = rr * 64 + cc * 2; return st * 1024 + (ob ^ (((ob >> 9) & 1) << 5)); }
__host__ __device__ __forceinline__ void stage_rc(int b, int& R, int& C) { const int st = b / 1024, sb = b % 1024, swz = sb ^ (((sb >> 9) & 1) << 5); R = (st >> 1) * 16 + swz / 64; C = (st & 1) * 32 + (swz % 64) / 2; }
__host__ __device__ __forceinline__ int perm32(int rho) { const int n = rho >> 4, i = rho & 15; return 8 * (i >> 2) + 4 * n + (i & 3); }

struct Unit { int pm, pn, e, mtl, cnt; };

struct DenseOrder {
    int nM, nN, nwg, G, c; const char* Bt;
    __device__ __forceinline__ void init(int M, int N, int G_, int c_, const void* Bt_) { nM = M / BM; nN = N / BM; nwg = nM * nN; G = G_; c = c_; Bt = (const char*)Bt_; }
    __device__ __forceinline__ bool next(int i, Unit& u) const {
        const long L = (long)i * G + c; if (L >= nwg) return false;
        int wgid = (int)L; { const int q = nwg / NXCD, r = nwg % NXCD, xcd = wgid % NXCD, off = wgid / NXCD; wgid = (xcd < r ? xcd * (q + 1) : r * (q + 1) + (xcd - r) * q) + off; }
        const int nig = WGM * nN, gid = wgid / nig, fm = gid * WGM, gsz = (nM - fm) < WGM ? (nM - fm) : WGM;
        u.pm = fm + ((wgid % nig) % gsz); u.pn = (wgid % nig) / gsz; u.e = 0; u.mtl = 0; u.cnt = 0; return true;
    }
    __device__ __forceinline__ unsigned arow_off(const Unit& u, int rl) const { return (unsigned)(u.pm * BM + rl) * (unsigned)(KD * 2); }
    __device__ __forceinline__ const char* bbase(const Unit& u) const { return Bt + (size_t)u.pn * (size_t)(BM * KD * 2); }
};
template <int NPN, bool GATHER, int ROWB> struct MoeOrder {
    const LAS int* tp; const LAS int* cn; int G, vcu, lane; const int* list; const char* Bt; size_t bstride;
    __device__ __forceinline__ bool next(int i, Unit& u) const {
        const int L = i * G + vcu, chunk = L >> 5, s = L & 31;
        const int mt = (NPN == 8) ? chunk * 4 + (s & 3) : chunk * 8 + (s & 7), pn = (NPN == 8) ? (s >> 2) : (s >> 3);
        const int MT = tp[32];
        if (mt >= MT) return false;
        const int lj = lane < 1 ? 1 : (lane > 32 ? 32 : lane);
        const unsigned long long bm = __ballot(lane >= 1 && lane <= 32 && tp[lj] <= mt);
        const int e = __builtin_amdgcn_readfirstlane(__popcll(bm));
        u.pm = mt; u.pn = pn; u.e = e; u.mtl = __builtin_amdgcn_readfirstlane(mt - tp[e]); u.cnt = __builtin_amdgcn_readfirstlane(cn[e]); return true;
    }
    __device__ __forceinline__ unsigned arow_off(const Unit& u, int rl) const {
        if (GATHER) { int pos = u.mtl * BM + rl; pos = pos < u.cnt ? pos : u.cnt - 1; const int p = list[u.e * LISTCAP + pos]; return (unsigned)(p >> 2) * (unsigned)ROWB; }
        else return (unsigned)(u.pm * BM + rl) * (unsigned)ROWB;
    }
    __device__ __forceinline__ const char* bbase(const Unit& u) const { return Bt + (size_t)u.e * bstride + (size_t)u.pn * (size_t)(BM * ROWB); }
};

typedef int i32x4 __attribute__((ext_vector_type(4)));
typedef int i32x8 __attribute__((ext_vector_type(8)));
template <class Epi, class Sched, bool FP8 = false>
__device__ __forceinline__ void gemm_phase(LAS unsigned char* lds, const char* Abase, const Sched& S, const Epi& E) {
    const int tid = threadIdx.x, wid = __builtin_amdgcn_readfirstlane(tid >> 6), lane = tid & 63, wr = wid >> 2, wc = wid & 3, fr = lane & 15, fq = lane >> 4;
    constexpr int ROWB = FP8 ? KD : KD * 2, nt = ROWB / (BK * 2);
    int RA[2]; unsigned CA2[2], voffB[2];
#pragma unroll
    for (int i = 0; i < 2; ++i) { int R, C; stage_rc(tid * 16 + i * 8192, R, C); const int Rb = Epi::PERM ? ((R & ~31) + perm32(R & 31)) : R;
        RA[i] = R; CA2[i] = (unsigned)C * 2u; voffB[i] = (unsigned)(Rb * ROWB + C * 2); }
    constexpr size_t kstep = (size_t)(BK * 2);
    constexpr size_t hstep = (size_t)HALF * ROWB;
    const unsigned ldsw = (unsigned)wid * 1024u;
    const int aoff = lds_byte(wr * 64 + fr, fq * 8), boff = lds_byte(wc * 32 + fr, fq * 8);
#define PG8_SA(b, h) (((b) * 2 + (h)) * HTB)
#define PG8_SB(b, h) ((4 + (b) * 2 + (h)) * HTB)
#define PG8_STAGE_B(bufoff, gbase) do { _Pragma("unroll") for (int _i = 0; _i < 2; ++_i) \
        __builtin_amdgcn_global_load_lds((const unsigned*)((const char*)(gbase) + voffB[_i]), (LAS unsigned*)(lds + (bufoff) + ldsw + _i * 8192), 16, 0, 0); } while (0)
#define PG8_STAGE_A(bufoff, offs, kb) do { _Pragma("unroll") for (int _i = 0; _i < 2; ++_i) \
        __builtin_amdgcn_global_load_lds((const unsigned*)(Abase + (size_t)(offs)[_i] + (size_t)(kb)), (LAS unsigned*)(lds + (bufoff) + ldsw + _i * 8192), 16, 0, 0); } while (0)
#define PG8_LD8(p) __builtin_shufflevector(*(const LAS i32x4*)(p), *(const LAS i32x4*)((p) + 1024), 0, 1, 2, 3, 4, 5, 6, 7)
#define PG8_LDA(dst, b, h) do { _Pragma("unroll") for (int m = 0; m < 4; ++m) { if constexpr (FP8) dst##8[m] = PG8_LD8(lds + PG8_SA(b, h) + aoff + m * 2048); else { _Pragma("unroll") for (int k = 0; k < 2; ++k) dst[m][k] = *(const LAS bf16x8*)(lds + PG8_SA(b, h) + aoff + m * 2048 + k * 1024); } } } while (0)
#define PG8_LDB(dst, b, h) do { _Pragma("unroll") for (int n = 0; n < 2; ++n) { if constexpr (FP8) dst##8[n] = PG8_LD8(lds + PG8_SB(b, h) + boff + n * 2048); else { _Pragma("unroll") for (int k = 0; k < 2; ++k) dst[n][k] = *(const LAS bf16x8*)(lds + PG8_SB(b, h) + boff + n * 2048 + k * 1024); } } } while (0)
#define PG8_MMA(ai, bj, At, Bt) do { __builtin_amdgcn_s_setprio(1); _Pragma("unroll") for (int m = 0; m < 4; ++m) _Pragma("unroll") for (int n = 0; n < 2; ++n) { \
        if constexpr (FP8) asm volatile("s_nop 1\n\tv_mfma_f32_16x16x128_f8f6f4 %0, %1, %2, %0" : "+v"(acc[ai][bj][m][n]) : "v"(Bt##8[n]), "v"(At##8[m])); \
        else { _Pragma("unroll") for (int k = 0; k < 2; ++k) acc[ai][bj][m][n] = __builtin_amdgcn_mfma_f32_16x16x32_bf16(Bt[n][k], At[m][k], acc[ai][bj][m][n], 0, 0, 0); } } \
        __builtin_amdgcn_s_setprio(0); } while (0)
#define PG8_WAIT_V(n) asm volatile("s_waitcnt vmcnt(" #n ")" ::: "memory")
#define PG8_WAIT_L(n) asm volatile("s_waitcnt lgkmcnt(" #n ")" ::: "memory")
#define PG8_BAR __builtin_amdgcn_s_barrier()
#define PG8_SCHED __builtin_amdgcn_sched_barrier(0)
    Unit cur, nxt; int ui = 0;
    if (!S.next(0, cur)) return;
    f32x4 acc[2][2][4][2];
#pragma unroll
    for (int a = 0; a < 2; ++a)
#pragma unroll
        for (int b = 0; b < 2; ++b)
#pragma unroll
            for (int m = 0; m < 4; ++m)
#pragma unroll
                for (int n = 0; n < 2; ++n) { acc[a][b][m][n] = (f32x4){0.f, 0.f, 0.f, 0.f}; asm volatile("" : "+v"(acc[a][b][m][n])); }
    bf16x8 At[4][2], B0[2][2], B1[2][2];
    i32x8 At8[4], B08[2], B18[2];
    unsigned ao[2][2], no[2][2];
#pragma unroll
    for (int h = 0; h < 2; ++h)
#pragma unroll
        for (int i = 0; i < 2; ++i) ao[h][i] = S.arow_off(cur, h * HALF + RA[i]) + CA2[i];
    const char* cB = S.bbase(cur);
    PG8_STAGE_B(PG8_SB(0, 0), cB); PG8_STAGE_B(PG8_SB(0, 1), cB + hstep); PG8_STAGE_A(PG8_SA(0, 0), ao[0], 0); PG8_STAGE_A(PG8_SA(0, 1), ao[1], 0);
    if (wr == 1) PG8_BAR;
    PG8_WAIT_V(2); PG8_BAR;
    PG8_STAGE_B(PG8_SB(1, 0), cB + kstep); PG8_STAGE_A(PG8_SA(1, 0), ao[0], kstep); PG8_STAGE_B(PG8_SB(1, 1), cB + hstep + kstep);
    PG8_WAIT_V(6); PG8_BAR;
    for (;;) {
        const bool has_next = S.next(ui + 1, nxt);
        const char* nB = cB;
        if (has_next) {
#pragma unroll
            for (int h = 0; h < 2; ++h)
#pragma unroll
                for (int i = 0; i < 2; ++i) no[h][i] = S.arow_off(nxt, h * HALF + RA[i]) + CA2[i];
            nB = S.bbase(nxt);
        } else {
#pragma unroll
            for (int h = 0; h < 2; ++h)
#pragma unroll
                for (int i = 0; i < 2; ++i) no[h][i] = ao[h][i];
        }
#pragma nounroll
        for (int t = 0; t < nt; t += 2) {
            const bool last = (t == nt - 2);
            const size_t kb1 = (size_t)(t + 1) * kstep;
            unsigned s2[2][2];
#pragma unroll
            for (int h = 0; h < 2; ++h)
#pragma unroll
                for (int i = 0; i < 2; ++i) s2[h][i] = last ? no[h][i] : ao[h][i];
            const size_t kb2 = last ? 0 : (size_t)(t + 2) * kstep, kb3 = kb2 + kstep;
            const char* b2 = last ? nB : cB + (size_t)(t + 2) * kstep; const char* b3 = b2 + kstep;
            PG8_LDB(B0, 0, 0); PG8_LDB(B1, 0, 1); PG8_SCHED; PG8_LDA(At, 0, 0); PG8_STAGE_A(PG8_SA(1, 1), ao[1], kb1);
            PG8_WAIT_V(8); PG8_WAIT_L(0); PG8_BAR; PG8_MMA(0, 0, At, B0); PG8_MMA(0, 1, At, B1); PG8_BAR; PG8_SCHED;
            PG8_LDA(At, 0, 1); PG8_STAGE_B(PG8_SB(0, 0), b2); PG8_STAGE_B(PG8_SB(0, 1), b2 + hstep); PG8_STAGE_A(PG8_SA(0, 0), s2[0], kb2);
            PG8_WAIT_V(8); PG8_WAIT_L(0); PG8_BAR; PG8_MMA(1, 0, At, B0); PG8_MMA(1, 1, At, B1); PG8_BAR; PG8_SCHED;
            PG8_LDB(B0, 1, 0); PG8_LDB(B1, 1, 1); PG8_SCHED; PG8_LDA(At, 1, 0); PG8_STAGE_A(PG8_SA(0, 1), s2[1], kb2);
            PG8_WAIT_V(8); PG8_WAIT_L(0); PG8_BAR; PG8_MMA(0, 0, At, B0); PG8_MMA(0, 1, At, B1); PG8_BAR; PG8_SCHED;
            PG8_LDA(At, 1, 1); PG8_STAGE_B(PG8_SB(1, 0), b3); PG8_STAGE_B(PG8_SB(1, 1), b3 + hstep); PG8_STAGE_A(PG8_SA(1, 0), s2[0], kb3);
            PG8_WAIT_V(8); PG8_WAIT_L(0); PG8_BAR; PG8_MMA(1, 0, At, B0); PG8_MMA(1, 1, At, B1); PG8_BAR; PG8_SCHED;
        }
        if (wr == 0) PG8_BAR;
        if constexpr (FP8) asm volatile("s_nop 15\n\ts_nop 7" ::: "memory");
        E(acc, cur, wr, wc, fr, fq);
        if (!has_next) break;
#pragma unroll
        for (int a = 0; a < 2; ++a)
#pragma unroll
            for (int b = 0; b < 2; ++b)
#pragma unroll
                for (int m = 0; m < 4; ++m)
#pragma unroll
                    for (int n = 0; n < 2; ++n) { acc[a][b][m][n] = (f32x4){0.f, 0.f, 0.f, 0.f}; asm volatile("" : "+v"(acc[a][b][m][n])); }
        cur = nxt; cB = nB; ++ui;
#pragma unroll
        for (int h = 0; h < 2; ++h)
#pragma unroll
            for (int i = 0; i < 2; ++i) ao[h][i] = no[h][i];
        if (wr == 1) PG8_BAR;
    }
    PG8_WAIT_V(0);
    PG8_BAR;
#undef PG8_SA
#undef PG8_SB
#undef PG8_STAGE_A
#undef PG8_STAGE_B
#undef PG8_LDA
#undef PG8_LDB
#undef PG8_MMA
#undef PG8_LD8
#undef PG8_WAIT_V
#undef PG8_WAIT_L
#undef PG8_BAR
#undef PG8_SCHED
}

struct EpiIn {
    static constexpr bool PERM = true;
    bf16* Q; size_t qkv_stride;
    __device__ __forceinline__ void operator()(const f32x4 (&acc)[2][2][4][2], const Unit& u, int wr, int wc, int fr, int fq) const {
        const int row0 = u.pm * BM + wr * 64 + fr; bf16* HG = Q + 3 * qkv_stride;
        if (u.pn < 6) {
            bf16* base = Q + (size_t)(u.pn >> 1) * qkv_stride; const float sc = u.pn < 2 ? QSCALE : 1.0f;
            const int col0 = (u.pn & 1) * 256 + wc * 32 + 8 * fq;
#pragma unroll
            for (int ai = 0; ai < 2; ++ai)
#pragma unroll
                for (int m = 0; m < 4; ++m) { bf16* rowp = base + (size_t)(row0 + ai * HALF + m * 16) * AW + col0;
#pragma unroll
                    for (int bj = 0; bj < 2; ++bj) { const f32x4 v0 = acc[ai][bj][m][0] * sc, v1 = acc[ai][bj][m][1] * sc;
                        u32x4 w; w.x = cvt_pk_bf16(v0[0], v0[1]); w.y = cvt_pk_bf16(v0[2], v0[3]); w.z = cvt_pk_bf16(v1[0], v1[1]); w.w = cvt_pk_bf16(v1[2], v1[3]);
                        *(u32x4*)(rowp + bj * HALF) = w; } }
        } else {
            const int col0 = (u.pn - 6) * 128 + wc * 32 + 8 * fq;
#pragma unroll
            for (int ai = 0; ai < 2; ++ai)
#pragma unroll
                for (int m = 0; m < 4; ++m) { bf16* rowp = HG + (size_t)(row0 + ai * HALF + m * 16) * AW + col0;
                    float o[8];
#pragma unroll
                    for (int n = 0; n < 2; ++n)
#pragma unroll
                        for (int j = 0; j < 4; ++j) o[n * 4 + j] = acc[ai][0][m][n][j] * sigmoidf_(acc[ai][1][m][n][j]);
                    u32x4 w; w.x = cvt_pk_bf16(o[0], o[1]); w.y = cvt_pk_bf16(o[2], o[3]); w.z = cvt_pk_bf16(o[4], o[5]); w.w = cvt_pk_bf16(o[6], o[7]);
                    *(u32x4*)rowp = w; }
        }
    }
};
struct EpiOut {
    static constexpr bool PERM = false;
    float* Y1; const bf16* XN;
    __device__ __forceinline__ void operator()(const f32x4 (&acc)[2][2][4][2], const Unit& u, int wr, int wc, int fr, int fq) const {
        const int row0 = u.pm * BM + wr * 64 + fr, col0 = u.pn * BM + wc * 32 + 4 * fq;
#pragma unroll
        for (int ai = 0; ai < 2; ++ai)
#pragma unroll
            for (int m = 0; m < 4; ++m) { const size_t ro = (size_t)(row0 + ai * HALF + m * 16) * DM + col0;
#pragma unroll
                for (int bj = 0; bj < 2; ++bj)
#pragma unroll
                    for (int n = 0; n < 2; ++n) { const u32x2 xw = *(const u32x2*)(XN + ro + bj * HALF + n * 16);
                        f32x4 o = acc[ai][bj][m][n]; o[0] += ALPHA * bf_lo(xw.x); o[1] += ALPHA * bf_hi(xw.x); o[2] += ALPHA * bf_lo(xw.y); o[3] += ALPHA * bf_hi(xw.y);
                        *(f32x4*)(Y1 + ro + bj * HALF + n * 16) = o; } }
    }
};
struct EpiSwiglu {
    static constexpr bool PERM = true;
    unsigned char* HID; const float* bgu;
    __device__ __forceinline__ void operator()(const f32x4 (&acc)[2][2][4][2], const Unit& u, int wr, int wc, int fr, int fq) const {
        const int row0 = u.pm * BM + wr * 64 + fr, ch0 = u.pn * 128 + wc * 32 + 8 * fq; constexpr float ISC = 1.0f / (SX8 * SW8);
        const float* bg = bgu + (size_t)u.e * 2048 + ch0; const float* bu = bg + 1024;
        f32x4 bgv[2], buv[2];
#pragma unroll
        for (int n = 0; n < 2; ++n) { bgv[n] = *(const f32x4*)(bg + 4 * n); buv[n] = *(const f32x4*)(bu + 4 * n); }
#pragma unroll
        for (int ai = 0; ai < 2; ++ai)
#pragma unroll
            for (int m = 0; m < 4; ++m) { unsigned char* rowp = HID + (size_t)(row0 + ai * HALF + m * 16) * DFF + ch0;
                float o[8];
#pragma unroll
                for (int n = 0; n < 2; ++n)
#pragma unroll
                    for (int j = 0; j < 4; ++j) { float g = acc[ai][0][m][n][j] * ISC + bgv[n][j], up = acc[ai][1][m][n][j] * ISC + buv[n][j];
                        g = fminf(g, 7.0f); up = fminf(fmaxf(up, -7.0f), 7.0f);
                        o[n * 4 + j] = g * sigmoidf_(1.702f * g) * (up + 1.0f) * SH8; }
                u32x2 w; w.x = pk4_fp8(o[0], o[1], o[2], o[3]); w.y = pk4_fp8(o[4], o[5], o[6], o[7]);
                *(u32x2*)rowp = w; }
    }
};
struct EpiDown {
    static constexpr bool PERM = true;
    bf16* YP; const float* bd; const int* list; const float* gatew;
    __device__ __forceinline__ void operator()(const f32x4 (&acc)[2][2][4][2], const Unit& u, int wr, int wc, int fr, int fq) const {
        const int rl0 = wr * 64 + fr, col0 = u.pn * BM + wc * 32 + 8 * fq;
        f32x4 bv[2][2];
#pragma unroll
        for (int bj = 0; bj < 2; ++bj)
#pragma unroll
            for (int n = 0; n < 2; ++n) bv[bj][n] = *(const f32x4*)(bd + (size_t)u.e * DM + col0 + bj * HALF + 4 * n);
#pragma unroll
        for (int ai = 0; ai < 2; ++ai)
#pragma unroll
            for (int m = 0; m < 4; ++m) { const int pos = u.mtl * BM + rl0 + ai * HALF + m * 16;
                if (pos < u.cnt) { const int p = list[u.e * LISTCAP + pos]; const float gw = gatew[p]; bf16* rowp = YP + (size_t)p * DM + col0;
#pragma unroll
                    for (int bj = 0; bj < 2; ++bj) { constexpr float ISC = 1.0f / (SH8 * SW8); const f32x4 v0 = (acc[ai][bj][m][0] * ISC + bv[bj][0]) * gw, v1 = (acc[ai][bj][m][1] * ISC + bv[bj][1]) * gw;
                        u32x4 w; w.x = cvt_pk_bf16(v0[0], v0[1]); w.y = cvt_pk_bf16(v0[2], v0[3]); w.z = cvt_pk_bf16(v1[0], v1[1]); w.w = cvt_pk_bf16(v1[2], v1[3]);
                        *(u32x4*)(rowp + bj * HALF) = w; } } }
    }
};
}

#define XB_TMO      128
#define XB_XCNT(j)  (256  + 64 * (j))
#define XB_XSUB(j)  (1280 + 64 * (j))
#define XB_XGEN(j)  (2304 + 64 * (j))
#define XB_TOP      3328
#define XB_TOPGEN   3392
#define XCD_BAR_WORDS 3456
#define XB_SPIN_CAP (1u << 18)
__device__ __forceinline__ unsigned xb_ld(unsigned* p)              { return __hip_atomic_load(p, __ATOMIC_RELAXED, __HIP_MEMORY_SCOPE_AGENT); }
__device__ __forceinline__ unsigned xb_add(unsigned* p, unsigned v) { return __hip_atomic_fetch_add(p, v, __ATOMIC_RELAXED, __HIP_MEMORY_SCOPE_AGENT); }
__device__ __forceinline__ unsigned xb_xcc_id() { return (unsigned)__builtin_amdgcn_s_getreg((3 << 11) | 20) & 0xFu; }
#define XB_SPIN(cond, bar) do { unsigned _sp = 0; while (cond) { __builtin_amdgcn_s_sleep(1); \
    if ((++_sp & 255u) == 0u) { if (xb_ld(&(bar)[XB_TMO])) break; if (_sp > XB_SPIN_CAP) { atomicAdd(&(bar)[XB_TMO], 1u); break; } } } } while (0)
struct XcdBarrier { unsigned* bar; unsigned x; volatile LAS unsigned* st; };
__device__ __forceinline__ XcdBarrier xcd_barrier_post(unsigned* bar, volatile LAS unsigned* st) {
    XcdBarrier b; b.bar = bar; b.x = xb_xcc_id(); b.st = st;
    if (threadIdx.x == 0) (void)xb_add(&bar[XB_XCNT(b.x)], 1u);
    return b;
}
__device__ __forceinline__ void xcd_barrier_complete(unsigned* bar, unsigned x, unsigned& nloc, unsigned& nx) {
    const unsigned G = gridDim.x * gridDim.y * gridDim.z;
    unsigned sum, cnt, mine, sp = 0u;
    for (;;) {
        sum = 0u; cnt = 0u; mine = 0u;
#pragma unroll
        for (unsigned j = 0; j < 16; ++j) { const unsigned c = xb_ld(&bar[XB_XCNT(j)]); sum += c; cnt += (c > 0u) ? 1u : 0u; mine = (j == x) ? c : mine; }
        if (sum == G) break;
        __builtin_amdgcn_s_sleep(1);
        if ((++sp & 255u) == 0u) { if (xb_ld(&bar[XB_TMO])) break; if (sp > XB_SPIN_CAP) { atomicAdd(&bar[XB_TMO], 1u); break; } }
    }
    nloc = mine > 0u ? mine : 1u; nx = cnt > 0u ? cnt : 1u;
}
__device__ __forceinline__ void xcd_barrier(const XcdBarrier& b) {
    asm volatile("s_waitcnt vmcnt(0)" ::: "memory");
    __syncthreads();
    if (threadIdx.x == 0) {
        unsigned* bar = b.bar;
        __builtin_amdgcn_s_waitcnt(0);
        unsigned nloc = b.st[0], nx = b.st[1];
        if (nloc == 0u) { xcd_barrier_complete(bar, b.x, nloc, nx); b.st[0] = nloc; b.st[1] = nx; }
        const unsigned old = xb_add(&bar[XB_XSUB(b.x)], 1u);
        const unsigned gen = old / nloc;
        if (old + 1u == (gen + 1u) * nloc) {
            __builtin_amdgcn_fence(__ATOMIC_RELEASE, "agent");
            asm volatile("s_waitcnt vmcnt(0)" ::: "memory");
            const unsigned og = xb_add(&bar[XB_TOP], 1u);
            const unsigned tg = og / nx;
            if (og + 1u == (tg + 1u) * nx) xb_add(&bar[XB_TOPGEN], 1u);
            else XB_SPIN(xb_ld(&bar[XB_TOPGEN]) == tg, bar);
            __builtin_amdgcn_fence(__ATOMIC_ACQUIRE, "agent");
            xb_add(&bar[XB_XGEN(b.x)], 1u);
            asm volatile("s_waitcnt vmcnt(0)" ::: "memory");
        } else {
            XB_SPIN(xb_ld(&bar[XB_XGEN(b.x)]) == gen, bar);
            __builtin_amdgcn_fence(__ATOMIC_ACQUIRE, "agent");
            asm volatile("s_waitcnt vmcnt(0)" ::: "memory");
        }
    }
    __syncthreads();
}

struct Frame {
    LAS unsigned char* lds; volatile LAS unsigned* MISC; gu32* ctl;
    int tid, lane, wave, vcu, G;
};
struct Args { const float* in[24]; float* out; unsigned char* ws; int ph_lo, ph_hi; };

__device__ __forceinline__ void p0_transpose_item(const float* W, int K, int N, bf16* WT, int k0, int n0, int drow0, LAS float* scr, int lane) {
#pragma unroll 8
    for (int i = 0; i < 32; ++i) { const int kk = 2 * i + (lane >> 5); scr[kk * 33 + (lane & 31)] = W[(size_t)(k0 + kk) * N + n0 + (lane & 31)]; }
    LDS_WAIT(); asm volatile("" ::: "memory");
    const int c = lane & 7;
#pragma unroll
    for (int j = 0; j < 4; ++j) { const int n = (lane >> 3) + 8 * j; const LAS float* s = scr + (8 * c) * 33 + n;
        u32x4 o; o.x = cvt_pk_bf16(s[0 * 33], s[1 * 33]); o.y = cvt_pk_bf16(s[2 * 33], s[3 * 33]); o.z = cvt_pk_bf16(s[4 * 33], s[5 * 33]); o.w = cvt_pk_bf16(s[6 * 33], s[7 * 33]);
        *(GAS u32x4*)(WT + (size_t)(drow0 + n) * K + k0 + 8 * c) = o; }
    LDS_WAIT(); asm volatile("" ::: "memory");
}
__device__ __forceinline__ void p0_transpose_item_fp8(const float* W, int K, int N, unsigned char* WT8, int k0, int n0, int drow0, LAS float* scr, int lane, float scale) {
#pragma unroll 8
    for (int i = 0; i < 32; ++i) { const int kk = 2 * i + (lane >> 5); scr[kk * 33 + (lane & 31)] = W[(size_t)(k0 + kk) * N + n0 + (lane & 31)]; }
    LDS_WAIT(); asm volatile("" ::: "memory");
    const int c = lane & 7;
#pragma unroll
    for (int j = 0; j < 4; ++j) { const int n = (lane >> 3) + 8 * j; const LAS float* s = scr + (8 * c) * 33 + n;
        u32x2 o; o.x = pk4_fp8(s[0 * 33] * scale, s[1 * 33] * scale, s[2 * 33] * scale, s[3 * 33] * scale); o.y = pk4_fp8(s[4 * 33] * scale, s[5 * 33] * scale, s[6 * 33] * scale, s[7 * 33] * scale);
        *(GAS u32x2*)(WT8 + (size_t)(drow0 + n) * K + k0 + 8 * c) = o; }
    LDS_WAIT(); asm volatile("" ::: "memory");
}
__device__ __forceinline__ void ln_row_to_bf16(const float* xrow, const float* g, const float* b, bf16* orow, int lane) {
    const GAS f32x4* xr = (const GAS f32x4*)xrow + lane;
    f32x4 v[4]; float s = 0.f;
#pragma unroll
    for (int j = 0; j < 4; ++j) { v[j] = xr[64 * j]; s += (v[j].x + v[j].y) + (v[j].z + v[j].w); }
    const float mean = wave_sum(s) * (1.f / DM); float s2 = 0.f;
#pragma unroll
    for (int j = 0; j < 4; ++j) { v[j] = v[j] - mean; s2 += (v[j].x * v[j].x + v[j].y * v[j].y) + (v[j].z * v[j].z + v[j].w * v[j].w); }
    const float rstd = 1.f / sqrtf(wave_sum(s2) * (1.f / DM) + LN_EPS);
    GAS u32x2* o8 = (GAS u32x2*)orow + lane;
#pragma unroll
    for (int j = 0; j < 4; ++j) { const f32x4 gg = *((const GAS f32x4*)g + lane + 64 * j), bb = *((const GAS f32x4*)b + lane + 64 * j);
        const f32x4 y = v[j] * rstd * gg + bb; u32x2 w; w.x = cvt_pk_bf16(y.x, y.y); w.y = cvt_pk_bf16(y.z, y.w); o8[64 * j] = w; }
}

namespace att {
constexpr int STG = 32768;
constexpr int LDS_WS = LDSCTL_OFF + 2048;
__device__ __forceinline__ void glds16(const void* gsrc, unsigned lds_dst) { unsigned keep;
    asm volatile("s_mov_b32 %0, m0\n\ts_mov_b32 m0, %2\n\ts_nop 0\n\tglobal_load_lds_dwordx4 %1, off\n\ts_mov_b32 m0, %0" : "=&s"(keep) : "v"(gsrc), "s"(lds_dst) : "memory"); }
__device__ __forceinline__ int crow(int r, int hi) { return (r & 3) + 8 * (r >> 2) + 4 * hi; }
__device__ __forceinline__ float swapmax(float m) { auto rr = __builtin_amdgcn_permlane32_swap(__float_as_uint(m), __float_as_uint(m), false, false); return fmaxf(__uint_as_float(rr[0]), __uint_as_float(rr[1])); }
__device__ __forceinline__ float swapsum(float m) { auto rr = __builtin_amdgcn_permlane32_swap(__float_as_uint(m), __float_as_uint(m), false, false); return __uint_as_float(rr[0]) + __uint_as_float(rr[1]); }
__device__ __forceinline__ s16x4 vtr(const LAS unsigned char* p) { typedef short v4i16_t __attribute__((ext_vector_type(4))); return __builtin_bit_cast(s16x4, __builtin_amdgcn_ds_read_tr16_b64_v4i16((LAS v4i16_t*)p)); }
}

__global__ void __launch_bounds__(NWAVES * 64, 2) hymba_fwd(Args args) {
    extern __shared__ __attribute__((aligned(16))) unsigned char lds_raw[];
    Frame F;
    F.lds = (LAS unsigned char*)lds_raw;
    F.MISC = (volatile LAS unsigned*)(F.lds + MISC_OFF);
    F.tid = threadIdx.x; F.lane = F.tid & 63; F.wave = __builtin_amdgcn_readfirstlane(F.tid >> 6);
    F.G = gridDim.x; { const int bx = blockIdx.x; F.vcu = (F.G % 8 == 0) ? (bx % 8) * (F.G / 8) + bx / 8 : bx; }
    unsigned char* ws = args.ws;
    F.ctl = (gu32*)(ws + WS_CTL);
    for (int u = F.tid; u < (LDS_BYTES - LDSCTL_OFF) / 4; u += NWAVES * 64) ((LAS unsigned*)(F.lds + LDSCTL_OFF))[u] = 0u;
    __syncthreads();
    XcdBarrier bar; bar.bar = (unsigned*)(F.ctl + CW_BAR); bar.x = 0; bar.st = nullptr;
    if (MK_N_LAUNCHES == 1) bar = xcd_barrier_post((unsigned*)(F.ctl + CW_BAR), F.MISC + 8);
    const int lo = args.ph_lo, hi = args.ph_hi;
#ifndef PH_MASK
#define PH_MASK 0xff
#endif
#define IN(k) (((PH_MASK >> (k)) & 1) && lo <= (k) && (k) < hi)
#define BOTH(k) (IN(k) && IN((k) + 1))
#ifndef REP_MASK
#define REP_MASK 0
#endif
#define NREP(k) (((REP_MASK >> (k)) & 1) ? 2 : 1)
#define GRID_BAR() do { xcd_barrier(bar); } while (0)
    const int lane = F.lane, wave = F.wave, tid = F.tid;
    const int gw = F.vcu * NWAVES + wave, NGW = F.G * NWAVES;

    const float* x_in = args.in[0];
    bf16* Win_t = (bf16*)(ws + WS_WIN); bf16* Wout_t = (bf16*)(ws + WS_WOUT); unsigned char* Wgu_t = ws + WS_WGU; unsigned char* Wd_t = ws + WS_WD;
    bf16* XN = (bf16*)(ws + WS_XN); bf16* Qb = (bf16*)(ws + WS_Q); bf16* Kb = (bf16*)(ws + WS_K); bf16* Vb = (bf16*)(ws + WS_V); bf16* HG = (bf16*)(ws + WS_HG);
    bf16* AC = (bf16*)(ws + WS_AC); float* Y1 = (float*)(ws + WS_Y1); bf16* X1 = (bf16*)(ws + WS_X1); unsigned char* HID = ws + WS_HID; bf16* YP = (bf16*)(ws + WS_YP); unsigned char* X1Q = ws + WS_X1Q;
    int* LIST = (int*)(ws + WS_LIST); float* GATEW = (float*)(ws + WS_GATE);

    if (IN(0)) {
      for (int rep_ = 0; rep_ < NREP(0); ++rep_) {
        LAS float* scr = (LAS float*)(F.lds + RING_OFF + wave * 16384);
        constexpr int I_IN = 16 * (IN_COLS / 32), I_OUT = 16 * 32, I_GU = 16 * 64, I_D = 16 * 32;
        constexpr int NITEMS = I_IN + I_OUT + NEXP * I_GU + NEXP * I_D;
        for (int it = gw; it < NITEMS; it += NGW) {
            int r = it;
            if (r < I_IN) { const int nblk = IN_COLS / 32, kb = r / nblk, nb = r % nblk, n0 = 32 * nb; int d;
                if (n0 < 1536) d = n0; else { const int j = n0 - 1536, g = j >= 512, ch = j & 511; d = 1536 + (ch >> 7) * 256 + g * 128 + (ch & 127); }
                p0_transpose_item(args.in[3], DM, IN_COLS, Win_t, 64 * kb, n0, d, scr, lane); continue; }
            r -= I_IN;
            if (r < I_OUT) { const int kb = r / 32, nb = r % 32; p0_transpose_item(args.in[13], DM, DM, Wout_t, 64 * kb, 32 * nb, 32 * nb, scr, lane); continue; }
            r -= I_OUT;
            if (r < NEXP * I_GU) { const int e = r / I_GU, q = r % I_GU, kb = q / 64, nb = q % 64, n0 = 32 * nb, g = n0 >= 1024, ch = n0 & 1023, d = (ch >> 7) * 256 + g * 128 + (ch & 127);
                p0_transpose_item_fp8(args.in[18] + (size_t)e * DM * 2048, DM, 2048, Wgu_t + (size_t)e * 2048 * DM, 64 * kb, n0, d, scr, lane, SW8); continue; }
            r -= NEXP * I_GU;
            { const int e = r / I_D, q = r % I_D, kb = q / 32, nb = q % 32;
                p0_transpose_item_fp8(args.in[20] + (size_t)e * DFF * DM, DFF, DM, Wd_t + (size_t)e * DM * DFF, 64 * kb, 32 * nb, 32 * nb, scr, lane, SW8); }
        }
        for (int m = gw; m < NTOK; m += NGW) ln_row_to_bf16(x_in + (size_t)m * DM, args.in[1], args.in[2], XN + (size_t)m * DM, lane);
        __syncthreads();
      }
        if (BOTH(0)) GRID_BAR();
    }

    if (IN(1)) {
        pg8::DenseOrder S; S.init(NTOK, IN_COLS, F.G, (int)blockIdx.x, Win_t);
        static_assert(WS_K - WS_Q == WS_V - WS_K && WS_HG - WS_V == WS_K - WS_Q, "Q|K|V|HG equally spaced");
        pg8::EpiIn E{Qb, (size_t)(WS_K - WS_Q) / 2};
        pg8::gemm_phase<pg8::EpiIn, pg8::DenseOrder>(F.lds + RING_OFF, (const char*)XN, S, E);
        if (NREP(1) == 2) { pg8::gemm_phase<pg8::EpiIn, pg8::DenseOrder>(F.lds + RING_OFF, (const char*)XN, S, E); }
        if (BOTH(1)) GRID_BAR();
    }

    if (IN(2)) {
        using namespace att;
      for (int rep_ = 0; rep_ < NREP(2); ++rep_) {
#ifndef NO_ATTN
        for (int un = F.vcu; un < 256; un += F.G)
        for (int ui = 0; ui < 2; ++ui) {
            const int bh = un >> 3, jj = un & 7, j = ui == 0 ? jj : 15 - jj, b = bh >> 2, h = bh & 3;
            const int r32 = lane & 31, hi = lane >> 5;
            const int comp = wave >> 2, qi = comp == 0 ? (wave & 3) : 3 - (wave & 3);
            const int p = qi == 0 ? j : (qi == 1 ? 31 - j : (qi == 2 ? 32 + j : 63 - j));
            const int dt = p >> 1;
            const int T = ((63 - j) >> 1) + 1;
            const size_t rowbase = (size_t)b * SEQ;
            const int q = 32 * p + r32;
            const float sl2 = LOG2E * (h == 0 ? 0.25f : h == 1 ? 0.0625f : h == 2 ? 0.015625f : 0.00390625f);
            bf16x8 qr[4];
#pragma unroll
            for (int d0 = 0; d0 < 4; ++d0) qr[d0] = *(const bf16x8*)(Qb + (rowbase + 32 * p + r32) * AW + h * 128 + comp * 64 + d0 * 16 + hi * 8);
            f32x16 o[4];
#pragma unroll
            for (int db = 0; db < 4; ++db)
#pragma unroll
                for (int r = 0; r < 16; ++r) o[db][r] = 0.f;
            float mrun = -INFINITY, lrun = 0.f;
            LAS float* wsf = (LAS float*)(F.lds + LDS_WS) + wave * 128;
            unsigned ksrc[2], vsrc[2];
#pragma unroll
            for (int i = 0; i < 2; ++i) { const int pc = 2 * wave + i; ksrc[i] = (unsigned)((rowbase + lane) * AW + h * 128 + pc * 8);
                vsrc[i] = (unsigned)((rowbase + (pc & 3) * 16 + (lane >> 2)) * AW + h * 128 + (pc >> 2) * 32 + (lane & 3) * 8); }
            const unsigned ldsb = (unsigned)(size_t)(F.lds + RING_OFF) + (unsigned)(2 * wave) * 1024u;
#define ATT_ISSUE(t, st) do { _Pragma("unroll") for (int _i = 0; _i < 2; ++_i) { \
                glds16(Kb + ksrc[_i] + (size_t)(t) * 64 * AW, (unsigned)__builtin_amdgcn_readfirstlane(ldsb + (st) * STG + _i * 1024)); \
                glds16(Vb + vsrc[_i] + (size_t)(t) * 64 * AW, (unsigned)__builtin_amdgcn_readfirstlane(ldsb + (st) * STG + 16384 + _i * 1024)); } } while (0)
#pragma unroll
            for (int d0 = 0; d0 < 4; ++d0) asm volatile("" : "+v"(qr[d0]));
            ATT_ISSUE(T - 1, 0);
            if (T >= 2) ATT_ISSUE(T - 2, 1);
            int st = 0, st2 = 2;
            const int vlane = ((lane >> 4) & 1) * 32 + (lane & 3) * 8 + (4 * hi + ((lane & 15) >> 2)) * 64;
            for (int it = 0; it < T; ++it) {
                const int t = T - 1 - it;
                if (it + 1 < T) asm volatile("s_waitcnt vmcnt(4)" ::: "memory"); else asm volatile("s_waitcnt vmcnt(0)" ::: "memory");
                asm volatile("s_waitcnt lgkmcnt(0)\n\ts_barrier" ::: "memory");
                if (it + 2 < T) ATT_ISSUE(t - 2, st2);
                if (t <= dt) {
                    const LAS unsigned char* Ks = F.lds + RING_OFF + st * STG;
                    const LAS unsigned char* Vs = Ks + 16384;
                    float sl2v = sl2; asm volatile("" : "+v"(sl2v));
                    const float fb = sl2v * (float)(64 * t + 4 * hi - q);
                    f32x16 p0, p1;
#pragma unroll
                    for (int r = 0; r < 16; ++r) { p0[r] = fb + sl2v * (float)((r & 3) + 8 * (r >> 2)); p1[r] = p0[r] + 32.0f * sl2v; }
#pragma unroll
                    for (int d0 = 0; d0 < 4; ++d0) {
                        const LAS unsigned char* kb = Ks + (comp * 8 + 2 * d0 + hi) * 1024 + r32 * 16;
                        const bf16x8 k0 = *(const LAS bf16x8*)kb, k1 = *(const LAS bf16x8*)(kb + 512);
                        p0 = __builtin_amdgcn_mfma_f32_32x32x16_bf16(k0, qr[d0], p0, 0, 0, 0);
                        p1 = __builtin_amdgcn_mfma_f32_32x32x16_bf16(k1, qr[d0], p1, 0, 0, 0);
                    }
                    if (t == dt) {
                        const int kb0 = 64 * t + 4 * hi - q;
#pragma unroll
                        for (int r = 0; r < 16; ++r) { const int rel = kb0 + (r & 3) + 8 * (r >> 2); if (rel > 0) p0[r] = -INFINITY; if (rel + 32 > 0) p1[r] = -INFINITY; }
                    }
                    float rm = fmaxf(p0[0], p1[0]);
#pragma unroll
                    for (int r = 1; r < 16; ++r) rm = fmaxf(rm, fmaxf(p0[r], p1[r]));
                    rm = swapmax(rm);
                    const float mn = fmaxf(mrun, rm);
                    if (__any(mn > mrun)) {
                        const float f = fast_exp2(mrun - mn);
                        lrun *= f; mrun = mn;
                        if (hi == 0) wsf[r32] = f;
                        LDS_WAIT();
#pragma unroll
                        for (int r = 0; r < 16; ++r) { const float fr_ = wsf[crow(r, hi)];
#pragma unroll
                            for (int db = 0; db < 4; ++db) o[db][r] *= fr_; }
                        LDS_WAIT();
                    }
                    float ls = 0.f;
#pragma unroll
                    for (int r = 0; r < 16; ++r) { p0[r] = fast_exp2(p0[r] - mrun); p1[r] = fast_exp2(p1[r] - mrun); ls += p0[r] + p1[r]; }
                    lrun += ls;
                    bf16x8 pa[4];
                    { u32x4 w0, w1, w2, w3;
                    w0.x = cvt_pk_bf16(p0[0], p0[1]); w0.y = cvt_pk_bf16(p0[2], p0[3]); w0.z = cvt_pk_bf16(p0[4], p0[5]); w0.w = cvt_pk_bf16(p0[6], p0[7]);
                    w1.x = cvt_pk_bf16(p0[8], p0[9]); w1.y = cvt_pk_bf16(p0[10], p0[11]); w1.z = cvt_pk_bf16(p0[12], p0[13]); w1.w = cvt_pk_bf16(p0[14], p0[15]);
                    w2.x = cvt_pk_bf16(p1[0], p1[1]); w2.y = cvt_pk_bf16(p1[2], p1[3]); w2.z = cvt_pk_bf16(p1[4], p1[5]); w2.w = cvt_pk_bf16(p1[6], p1[7]);
                    w3.x = cvt_pk_bf16(p1[8], p1[9]); w3.y = cvt_pk_bf16(p1[10], p1[11]); w3.z = cvt_pk_bf16(p1[12], p1[13]); w3.w = cvt_pk_bf16(p1[14], p1[15]);
                    pa[0] = __builtin_bit_cast(bf16x8, w0); pa[1] = __builtin_bit_cast(bf16x8, w1); pa[2] = __builtin_bit_cast(bf16x8, w2); pa[3] = __builtin_bit_cast(bf16x8, w3); }
#pragma unroll
                    for (int db = 0; db < 4; ++db)
#pragma unroll
                        for (int ks = 0; ks < 4; ++ks) {
                            const LAS unsigned char* vp = Vs + (db * 4 + ks) * 1024 + vlane;
                            const s16x4 vl = vtr(vp), vh = vtr(vp + 512);
                            const bf16x8 vf = (bf16x8){vl[0], vl[1], vl[2], vl[3], vh[0], vh[1], vh[2], vh[3]};
                            o[db] = __builtin_amdgcn_mfma_f32_32x32x16_bf16(pa[ks], vf, o[db], 0, 0, 0);
                        }
                }
                st = (st == 2) ? 0 : st + 1; st2 = (st2 == 2) ? 0 : st2 + 1;
            }
#undef ATT_ISSUE
            asm volatile("s_waitcnt lgkmcnt(0)\n\ts_barrier" ::: "memory");
            {
                int lane_o = lane; asm volatile("" : "+v"(lane_o));
                const int r32o = lane_o & 31, hio = lane_o >> 5;
                LAS float* wsf2 = (LAS float*)(F.lds + LDS_WS) + wave * 128;
                LAS float* XB = (LAS float*)(F.lds + RING_OFF) + qi * 4096 + lane_o;
                const float linv = fast_rcp(swapsum(lrun));
                if (comp == 1) {
                    float lam;
                    { const float a = args.in[4][lane_o] * args.in[5][lane_o], bb2 = args.in[6][lane_o] * args.in[7][lane_o];
                      lam = __expf(wave_sum(a)) - __expf(wave_sum(bb2)) + LAMBDA_INIT; }
                    if (hio == 0) wsf2[r32o] = lam * linv;
                    LDS_WAIT();
#pragma unroll
                    for (int r = 0; r < 16; ++r) { const float a1 = wsf2[crow(r, hio)];
#pragma unroll
                        for (int db = 0; db < 4; ++db) XB[(db * 16 + r) * 64] = o[db][r] * a1; }
                }
                asm volatile("s_waitcnt lgkmcnt(0)\n\ts_barrier" ::: "memory");
                if (comp == 0) {
                    if (hio == 0) wsf2[r32o] = linv;
                    LDS_WAIT();
                    float gsub[4];
#pragma unroll
                    for (int db = 0; db < 4; ++db) gsub[db] = args.in[8][db * 32 + r32o] * (1.0f - LAMBDA_INIT);
#pragma unroll
                    for (int r = 0; r < 16; ++r) {
                        const int qq = crow(r, hio); const float a0 = wsf2[qq];
                        float v[4], ss = 0.f;
#pragma unroll
                        for (int db = 0; db < 4; ++db) { v[db] = o[db][r] * a0 - XB[(db * 16 + r) * 64]; ss += v[db] * v[db]; }
                        ss += __shfl_xor(ss, 1); ss += __shfl_xor(ss, 2); ss += __shfl_xor(ss, 4); ss += __shfl_xor(ss, 8); ss += __shfl_xor(ss, 16);
                        const float rs = 1.0f / sqrtf(ss * (1.0f / 128.0f) + LN_EPS);
                        bf16* op = AC + (rowbase + 32 * p + qq) * DM + h * 128 + r32o;
#pragma unroll
                        for (int db = 0; db < 4; ++db) op[db * 32] = (bf16)(cvt_pk_bf16(v[db] * rs * gsub[db], 0.f) & 0xffffu);
                    }
                }
            }
            asm volatile("s_waitcnt lgkmcnt(0)\n\ts_barrier" ::: "memory");
        }
#endif
#ifndef NO_CONV
        {
            LAS float* WP = (LAS float*)(F.lds + RING_OFF);
            for (int idx = tid; idx < 45 * 512; idx += NWAVES * 64) { const int jj = idx >> 9, ch = idx & 511, j = jj - 7; WP[idx] = (j >= 0 && j <= 30) ? args.in[9][j * 512 + ch] : 0.f; }
            __syncthreads();
            const int ch0 = lane * 8;
            for (int item = gw; item < NTOK / 8; item += NGW) {
                const int t0 = item * 8, tpos = t0 & (SEQ - 1);
                float acc[8][8];
                { const f32x4 b0 = *(const f32x4*)(args.in[10] + ch0), b1 = *(const f32x4*)(args.in[10] + ch0 + 4);
#pragma unroll
                  for (int tt = 0; tt < 8; ++tt) { acc[tt][0] = b0[0]; acc[tt][1] = b0[1]; acc[tt][2] = b0[2]; acc[tt][3] = b0[3]; acc[tt][4] = b1[0]; acc[tt][5] = b1[1]; acc[tt][6] = b1[2]; acc[tt][7] = b1[3]; } }
                for (int i = 0; i < 38; ++i) {
                    if (tpos - 30 + i < 0) continue;
                    const u32x4 hw = *(const u32x4*)(HG + (size_t)(t0 - 30 + i) * AW + ch0);
                    float hv[8]; hv[0] = bf_lo(hw.x); hv[1] = bf_hi(hw.x); hv[2] = bf_lo(hw.y); hv[3] = bf_hi(hw.y); hv[4] = bf_lo(hw.z); hv[5] = bf_hi(hw.z); hv[6] = bf_lo(hw.w); hv[7] = bf_hi(hw.w);
                    const LAS float* wr_ = WP + i * 512 + ch0;
#pragma unroll
                    for (int tt = 0; tt < 8; ++tt) { const f32x4 w0 = *(const LAS f32x4*)(wr_ + (7 - tt) * 512), w1 = *(const LAS f32x4*)(wr_ + (7 - tt) * 512 + 4);
                        acc[tt][0] += w0[0] * hv[0]; acc[tt][1] += w0[1] * hv[1]; acc[tt][2] += w0[2] * hv[2]; acc[tt][3] += w0[3] * hv[3];
                        acc[tt][4] += w1[0] * hv[4]; acc[tt][5] += w1[1] * hv[5]; acc[tt][6] += w1[2] * hv[6]; acc[tt][7] += w1[3] * hv[7]; }
                }
                const f32x4 g0 = *(const f32x4*)(args.in[11] + ch0), g1 = *(const f32x4*)(args.in[11] + ch0 + 4), c0 = *(const f32x4*)(args.in[12] + ch0), c1 = *(const f32x4*)(args.in[12] + ch0 + 4);
#pragma unroll
                for (int tt = 0; tt < 8; ++tt) {
                    float s = 0.f;
#pragma unroll
                    for (int k = 0; k < 8; ++k) s += acc[tt][k];
                    const float mean = wave_sum(s) * (1.0f / 512.0f); float s2 = 0.f;
#pragma unroll
                    for (int k = 0; k < 8; ++k) { acc[tt][k] -= mean; s2 += acc[tt][k] * acc[tt][k]; }
                    const float rstd = 1.0f / sqrtf(wave_sum(s2) * (1.0f / 512.0f) + LN_EPS);
                    float y[8];
#pragma unroll
                    for (int k = 0; k < 8; ++k) { const float gg = k < 4 ? g0[k & 3] : g1[k & 3], cc = k < 4 ? c0[k & 3] : c1[k & 3]; const float v = acc[tt][k] * rstd * gg + cc; y[k] = v * sigmoidf_(v); }
                    u32x4 w; w.x = cvt_pk_bf16(y[0], y[1]); w.y = cvt_pk_bf16(y[2], y[3]); w.z = cvt_pk_bf16(y[4], y[5]); w.w = cvt_pk_bf16(y[6], y[7]);
                    *(u32x4*)(AC + (size_t)(t0 + tt) * DM + 512 + ch0) = w;
                }
            }
            __syncthreads();
        }
#endif
      }
        if (BOTH(2)) GRID_BAR();
    }

    if (IN(3)) {
        pg8::DenseOrder S; S.init(NTOK, DM, F.G, (int)blockIdx.x, Wout_t);
        pg8::EpiOut E{Y1, XN};
        pg8::gemm_phase<pg8::EpiOut, pg8::DenseOrder>(F.lds + RING_OFF, (const char*)AC, S, E);
        if (NREP(3) == 2) { pg8::gemm_phase<pg8::EpiOut, pg8::DenseOrder>(F.lds + RING_OFF, (const char*)AC, S, E); }
        if (BOTH(3)) GRID_BAR();
    }

    if (IN(4)) {
        constexpr int XSTR = 1028;
        LAS float* XS = (LAS float*)(F.lds + RING_OFF);
        LAS float* PL = (LAS float*)(F.lds + RING_OFF + 65792);
        LAS float* LG = (LAS float*)(F.lds + RING_OFF + 82176);
        LAS int* SEL = (LAS int*)(F.lds + RING_OFF + 84224);
        LAS float* GT = (LAS float*)(F.lds + RING_OFF + 85248);
        LAS int* RK = (LAS int*)(F.lds + RING_OFF + 86272);
        LAS int* LCNT = (LAS int*)(F.lds + RING_OFF + 87296);
        LAS int* GBASE = (LAS int*)(F.lds + RING_OFF + 87424);
        if (tid < 32) LCNT[tid] = 0;
        float rwf[32][2];
#pragma unroll
        for (int s = 0; s < 32; ++s) { const int k = 128 * wave + 4 * s + (lane >> 4); rwf[s][0] = args.in[16][k * 32 + (lane & 15)]; rwf[s][1] = args.in[16][k * 32 + 16 + (lane & 15)]; }
        __syncthreads();
        int gi = 0;
        for (int g = blockIdx.x; g < NTOK / 16; g += F.G, ++gi) {
#pragma unroll
            for (int rr = 0; rr < 2; ++rr) {
                const int lr = 2 * wave + rr; const size_t row = (size_t)g * 16 + lr;
                const GAS f32x4* xr = (const GAS f32x4*)(Y1 + row * DM) + lane;
                f32x4 v[4]; float s = 0.f;
#pragma unroll
                for (int j = 0; j < 4; ++j) { v[j] = xr[64 * j]; s += (v[j].x + v[j].y) + (v[j].z + v[j].w); }
                const float mean = wave_sum(s) * (1.f / DM); float s2 = 0.f;
#pragma unroll
                for (int j = 0; j < 4; ++j) { v[j] = v[j] - mean; s2 += (v[j].x * v[j].x + v[j].y * v[j].y) + (v[j].z * v[j].z + v[j].w * v[j].w); }
                const float rstd = 1.f / sqrtf(wave_sum(s2) * (1.f / DM) + LN_EPS);
                GAS u32x2* o8 = (GAS u32x2*)(X1 + row * DM) + lane;
#pragma unroll
                for (int j = 0; j < 4; ++j) { const f32x4 gg = *((const GAS f32x4*)args.in[14] + lane + 64 * j), bb = *((const GAS f32x4*)args.in[15] + lane + 64 * j);
                    const f32x4 y = v[j] * rstd * gg + bb; u32x2 w; w.x = cvt_pk_bf16(y.x, y.y); w.y = cvt_pk_bf16(y.z, y.w); o8[64 * j] = w;
                    *((GAS unsigned*)(X1Q + row * DM) + lane + 64 * j) = pk4_fp8(y.x * SX8, y.y * SX8, y.z * SX8, y.w * SX8);
                    *(LAS f32x4*)(XS + lr * XSTR + 4 * lane + 256 * j) = y; }
            }
            __syncthreads();
            {
                f32x4 a0 = (f32x4){0.f, 0.f, 0.f, 0.f}, a1 = a0;
                const LAS float* xp = XS + (lane & 15) * XSTR + 128 * wave + (lane >> 4);
#pragma unroll
                for (int s = 0; s < 32; ++s) { const float a = xp[4 * s];
                    a0 = __builtin_amdgcn_mfma_f32_16x16x4f32(a, rwf[s][0], a0, 0, 0, 0);
                    a1 = __builtin_amdgcn_mfma_f32_16x16x4f32(a, rwf[s][1], a1, 0, 0, 0); }
#pragma unroll
                for (int r = 0; r < 4; ++r) { PL[(wave * 16 + 4 * (lane >> 4) + r) * 32 + (lane & 15)] = a0[r]; PL[(wave * 16 + 4 * (lane >> 4) + r) * 32 + 16 + (lane & 15)] = a1[r]; }
            }
            __syncthreads();
            { const int row = tid >> 5, e = tid & 31; float s = args.in[17][e];
#pragma unroll
              for (int w = 0; w < 8; ++w) s += PL[(w * 16 + row) * 32 + e];
              LG[row * 32 + e] = s; }
            __syncthreads();
            if (tid < 16) {
                float lv[32];
#pragma unroll
                for (int e = 0; e < 32; ++e) lv[e] = LG[tid * 32 + e];
                int se[4]; float sv[4];
#pragma unroll
                for (int k = 0; k < 4; ++k) { float best = -INFINITY; int bi = 0;
#pragma unroll
                    for (int e = 0; e < 32; ++e) { const bool take = lv[e] > best; best = take ? lv[e] : best; bi = take ? e : bi; }
                    se[k] = bi; sv[k] = best;
#pragma unroll
                    for (int e = 0; e < 32; ++e) lv[e] = (e == bi) ? -INFINITY : lv[e]; }
                float ex[4], es = 0.f;
#pragma unroll
                for (int k = 0; k < 4; ++k) { ex[k] = __expf(sv[k] - sv[0]); es += ex[k]; }
                const float inv = 1.0f / es; const int lrow = gi * 16 + tid;
#pragma unroll
                for (int k = 0; k < 4; ++k) { SEL[lrow * 4 + k] = se[k]; GT[lrow * 4 + k] = ex[k] * inv; RK[lrow * 4 + k] = atomicAdd((int*)&LCNT[se[k]], 1); }
            }
        }
        __syncthreads();
        if (tid < 32) GBASE[tid] = (int)__hip_atomic_fetch_add(F.ctl + CW_GCNT + 64 * tid, (unsigned)LCNT[tid], RLX_AGENT);
        __syncthreads();
        if (tid < 256) {
            const int lrow = tid >> 2, k = tid & 3, gidx = lrow >> 4;
            if (gidx < gi) { const int g = blockIdx.x + gidx * F.G, token = g * 16 + (lrow & 15), p = token * 4 + k, e = SEL[lrow * 4 + k];
                LIST[e * LISTCAP + GBASE[e] + RK[lrow * 4 + k]] = p; GATEW[p] = GT[lrow * 4 + k]; }
        }
        __syncthreads();
        if (BOTH(4)) GRID_BAR();
    }

    if (IN(5) || IN(6)) {
        LAS int* TP = (LAS int*)(F.lds + MOE_TP_OFF); LAS int* CN = TP + 64;
        if (tid < 32) CN[tid] = (int)__hip_atomic_load(F.ctl + CW_GCNT + 64 * tid, RLX_AGENT);
        __syncthreads();
        if (tid == 0) { int a = 0; for (int e = 0; e < 32; ++e) { TP[e] = a; a += (CN[e] + 255) >> 8; } TP[32] = a; }
        __syncthreads();
    }
    if (IN(5)) {
        pg8::MoeOrder<8, true, 1024> S{(const LAS int*)(F.lds + MOE_TP_OFF), (const LAS int*)(F.lds + MOE_TP_OFF) + 64, F.G, F.vcu, lane, LIST, (const char*)Wgu_t, (size_t)2048 * DM};
        pg8::EpiSwiglu E{HID, args.in[19]};
        pg8::gemm_phase<pg8::EpiSwiglu, pg8::MoeOrder<8, true, 1024>, true>(F.lds + RING_OFF, (const char*)X1Q, S, E);
        if (NREP(5) == 2) { pg8::gemm_phase<pg8::EpiSwiglu, pg8::MoeOrder<8, true, 1024>, true>(F.lds + RING_OFF, (const char*)X1Q, S, E); }
        if (BOTH(5)) GRID_BAR();
    }
    if (IN(6)) {
        pg8::MoeOrder<4, false, 1024> S{(const LAS int*)(F.lds + MOE_TP_OFF), (const LAS int*)(F.lds + MOE_TP_OFF) + 64, F.G, F.vcu, lane, LIST, (const char*)Wd_t, (size_t)DM * DFF};
        pg8::EpiDown E{YP, args.in[21], LIST, GATEW};
        pg8::gemm_phase<pg8::EpiDown, pg8::MoeOrder<4, false, 1024>, true>(F.lds + RING_OFF, (const char*)HID, S, E);
        if (NREP(6) == 2) { pg8::gemm_phase<pg8::EpiDown, pg8::MoeOrder<4, false, 1024>, true>(F.lds + RING_OFF, (const char*)HID, S, E); }
        if (BOTH(6)) GRID_BAR();
    }
    if (IN(7)) {
        const unsigned bad = (MK_N_LAUNCHES == 1) ? __hip_atomic_load((gu32*)(F.ctl + CW_BAR + XB_TMO), RLX_AGENT) : 0u;
        for (int rep_ = 0; rep_ < NREP(7); ++rep_)
        for (int row = gw; row < NTOK; row += NGW) {
            float v[16];
#pragma unroll
            for (int j = 0; j < 2; ++j) { const u32x4 xw = *(const u32x4*)(X1 + (size_t)row * DM + 8 * lane + 512 * j);
                v[8 * j + 0] = ALPHA * bf_lo(xw.x); v[8 * j + 1] = ALPHA * bf_hi(xw.x); v[8 * j + 2] = ALPHA * bf_lo(xw.y); v[8 * j + 3] = ALPHA * bf_hi(xw.y);
                v[8 * j + 4] = ALPHA * bf_lo(xw.z); v[8 * j + 5] = ALPHA * bf_hi(xw.z); v[8 * j + 6] = ALPHA * bf_lo(xw.w); v[8 * j + 7] = ALPHA * bf_hi(xw.w); }
#pragma unroll
            for (int k = 0; k < 4; ++k)
#pragma unroll
                for (int j = 0; j < 2; ++j) { const u32x4 yw = *(const u32x4*)(YP + ((size_t)row * 4 + k) * DM + 8 * lane + 512 * j);
                    v[8 * j + 0] += bf_lo(yw.x); v[8 * j + 1] += bf_hi(yw.x); v[8 * j + 2] += bf_lo(yw.y); v[8 * j + 3] += bf_hi(yw.y);
                    v[8 * j + 4] += bf_lo(yw.z); v[8 * j + 5] += bf_hi(yw.z); v[8 * j + 6] += bf_lo(yw.w); v[8 * j + 7] += bf_hi(yw.w); }
            float s = 0.f;
#pragma unroll
            for (int i = 0; i < 16; ++i) s += v[i];
            const float mean = wave_sum(s) * (1.f / DM); float s2 = 0.f;
#pragma unroll
            for (int i = 0; i < 16; ++i) { v[i] -= mean; s2 += v[i] * v[i]; }
            const float rstd = 1.f / sqrtf(wave_sum(s2) * (1.f / DM) + LN_EPS);
#pragma unroll
            for (int j = 0; j < 2; ++j)
#pragma unroll
                for (int hh = 0; hh < 2; ++hh) { const int c0 = 8 * lane + 512 * j + 4 * hh;
                    const f32x4 gg = *(const f32x4*)(args.in[22] + c0), bb = *(const f32x4*)(args.in[23] + c0);
                    f32x4 o; o[0] = v[8 * j + 4 * hh + 0] * rstd * gg[0] + bb[0]; o[1] = v[8 * j + 4 * hh + 1] * rstd * gg[1] + bb[1]; o[2] = v[8 * j + 4 * hh + 2] * rstd * gg[2] + bb[2]; o[3] = v[8 * j + 4 * hh + 3] * rstd * gg[3] + bb[3];
                    if (bad) { const float qn = __builtin_nanf(""); o = (f32x4){qn, qn, qn, qn}; }
                    *(f32x4*)(args.out + (size_t)row * DM + c0) = o; }
        }
    }
#undef IN
#undef BOTH
#undef GRID_BAR
}

extern "C" void kernel_launch(void* const* d_in, const int* in_sizes, int n_in, void* d_out, int out_size, void* d_ws, size_t ws_size, hipStream_t stream) {
    static int grid = 0;
    if (grid == 0) {
        if (n_in != 24 || in_sizes[0] != NTOK * DM || out_size != NTOK * DM || ws_size < WS_END) { fprintf(stderr, "kernel_launch: unexpected shapes (n_in %d, in0 %d, out %d, ws %zu); nothing launched\n", n_in, n_in > 0 ? in_sizes[0] : -1, out_size, ws_size); grid = -1; return; }
        int dev = 0, cus = 0, per_cu = 0;
        if (hipGetDevice(&dev) != hipSuccess || hipDeviceGetAttribute(&cus, hipDeviceAttributeMultiprocessorCount, dev) != hipSuccess) { grid = -1; return; }
        if (hipFuncSetAttribute((const void*)hymba_fwd, hipFuncAttributeMaxDynamicSharedMemorySize, LDS_BYTES) != hipSuccess) { fprintf(stderr, "kernel_launch: hipFuncSetAttribute failed\n"); grid = -1; return; }
        if (hipOccupancyMaxActiveBlocksPerMultiprocessor(&per_cu, (const void*)hymba_fwd, NWAVES * 64, LDS_BYTES) != hipSuccess || per_cu < 1)
            fprintf(stderr, "kernel_launch: note: occupancy query reports %d workgroups per CU\n", per_cu);
        (void)hipGetLastError();
        grid = cus;
        if (grid != 256) fprintf(stderr, "kernel_launch: %d CUs; this kernel is laid out for 256\n", grid);
    }
    if (grid < 0) return;
    (void)hipMemsetAsync((char*)d_ws + WS_CTL, 0, CTL_ZERO_BYTES, stream);
    Args a{};
    for (int i = 0; i < 24; ++i) a.in[i] = (const float*)d_in[i];
    a.out = (float*)d_out; a.ws = (unsigned char*)d_ws;
    if (MK_N_LAUNCHES == 1) { a.ph_lo = 0; a.ph_hi = 8; hipLaunchKernelGGL(hymba_fwd, dim3(grid), dim3(NWAVES * 64), LDS_BYTES, stream, a); }
    else for (int li = 0; li < 8; ++li) { a.ph_lo = li; a.ph_hi = li + 1; hipLaunchKernelGGL(hymba_fwd, dim3(grid), dim3(NWAVES * 64), LDS_BYTES, stream, a); }
}
```

```cpp
#include <hip/hip_runtime.h>
#include <cstdio>
#include <cstdint>

#ifndef MK_N_LAUNCHES
#define MK_N_LAUNCHES 1
#endif

#define GAS __attribute__((address_space(1)))
#define LAS __attribute__((address_space(3)))
typedef unsigned short bf16;
typedef short bf16x8 __attribute__((ext_vector_type(8)));
typedef short s16x4 __attribute__((ext_vector_type(4)));
typedef float f32x2 __attribute__((ext_vector_type(2)));
typedef float f32x4 __attribute__((ext_vector_type(4)));
typedef float f32x16 __attribute__((ext_vector_type(16)));
typedef unsigned u32x2 __attribute__((ext_vector_type(2)));
typedef unsigned u32x4 __attribute__((ext_vector_type(4)));
typedef GAS unsigned gu32;
#define RLX_AGENT __ATOMIC_RELAXED, __HIP_MEMORY_SCOPE_AGENT
#define LDS_WAIT() asm volatile("s_waitcnt lgkmcnt(0)" ::: "memory")
#define VM_WAIT() asm volatile("s_waitcnt vmcnt(0)" ::: "memory")

constexpr int NTOK = 16384, DM = 1024, SEQ = 2048;
constexpr int IN_COLS = 2560, AW = 512;
constexpr int NEXP = 32, TOPK = 4, DFF = 1024, NPAIR = NTOK * TOPK;
constexpr int LISTCAP = NTOK;
constexpr int HIDROWS = NPAIR + NEXP * 256;
constexpr float LN_EPS = 1e-5f;
constexpr float ALPHA = 1.189207115002721f;
constexpr float LOG2E = 1.4426950408889634f;
constexpr float QSCALE = 0.125f * LOG2E;
constexpr float LAMBDA_INIT = 0.2f;
constexpr int NWAVES = 8;
constexpr float SX8 = 4.0f, SW8 = 64.0f, SH8 = 4.0f;

constexpr size_t MiB = 1u << 20;
constexpr size_t WS_CTL = 0, CTL_ZERO_BYTES = 1 * MiB;
constexpr size_t WS_WIN = 2 * MiB;
constexpr size_t WS_WOUT = 8 * MiB;
constexpr size_t WS_WGU = 16 * MiB;
constexpr size_t WS_WD = 144 * MiB;
constexpr size_t WS_XN = 208 * MiB;
constexpr size_t WS_Q = 240 * MiB, WS_K = 256 * MiB, WS_V = 272 * MiB, WS_HG = 288 * MiB;
constexpr size_t WS_AC = 304 * MiB;
constexpr size_t WS_Y1 = 336 * MiB;
constexpr size_t WS_X1 = 400 * MiB;
constexpr size_t WS_HID = 432 * MiB;
constexpr size_t WS_YP = 576 * MiB;
constexpr size_t WS_LIST = 704 * MiB;
constexpr size_t WS_GATE = 706 * MiB;
constexpr size_t WS_X1Q = 708 * MiB;
constexpr size_t WS_END = 724 * MiB;
constexpr int CW_TMO = 0;
constexpr int CW_BAR = 4096;
constexpr int CW_GCNT = 8192;

constexpr int RING_OFF = 0, RING_BYTES = 131072;
constexpr int LDSCTL_OFF = RING_BYTES, MISC_OFF = LDSCTL_OFF + 320;
constexpr int MOE_TP_OFF = LDSCTL_OFF + 1024;
constexpr int LDS_BYTES = 147456;

__device__ __forceinline__ unsigned cvt_pk_bf16(float lo, float hi) { unsigned r; asm volatile("v_cvt_pk_bf16_f32 %0, %1, %2" : "=v"(r) : "v"(lo), "v"(hi)); return r; }
__device__ __forceinline__ unsigned pk4_fp8(float a, float b, float c, float d) { int w = 0; w = __builtin_amdgcn_cvt_pk_fp8_f32(a, b, w, false); w = __builtin_amdgcn_cvt_pk_fp8_f32(c, d, w, true); return (unsigned)w; }
__device__ __forceinline__ float bf_lo(unsigned w) { return __uint_as_float(w << 16); }
__device__ __forceinline__ float bf_hi(unsigned w) { return __uint_as_float(w & 0xffff0000u); }
__device__ __forceinline__ float fast_exp2(float x) { return __builtin_amdgcn_exp2f(x); }
__device__ __forceinline__ float fast_rcp(float x) { return __builtin_amdgcn_rcpf(x); }
__device__ __forceinline__ float sigmoidf_(float x) { return fast_rcp(1.0f + fast_exp2(-LOG2E * x)); }
__device__ __forceinline__ float wave_sum(float v) {
#pragma unroll
    for (int o = 1; o < 64; o <<= 1) v += __shfl_xor(v, o);
    return v;
}

namespace pg8 {
constexpr int BM = 256, BK = 64, HALF = 128, HTB = HALF * BK * 2, STAGE_BYTES = 8 * HTB, NXCD = 8, WGM = 8, KD = 1024;
__host__ __device__ __forceinline__ int lds_byte(int r, int c) { const int st = (r >> 4) * 2 + (c >> 5), rr = r & 15, cc = c & 31, ob = rr * 64 + cc * 2; return st * 1024 + (ob ^ (((ob >> 9) & 1) << 5)); }
__host__ __device__ __forceinline__ void stage_rc(int b, int& R, int& C) { const int st = b / 1024, sb = b % 1024, swz = sb ^ (((sb >> 9) & 1) << 5); R = (st >> 1) * 16 + swz / 64; C = (st & 1) * 32 + (swz % 64) / 2; }
__host__ __device__ __forceinline__ int perm32(int rho) { const int n = rho >> 4, i = rho & 15; return 8 * (i >> 2) + 4 * n + (i & 3); }

struct Unit { int pm, pn, e, mtl, cnt; };

struct DenseOrder {
    int nM, nN, nwg, G, c; const char* Bt;
    __device__ __forceinline__ void init(int M, int N, int G_, int c_, const void* Bt_) { nM = M / BM; nN = N / BM; nwg = nM * nN; G = G_; c = c_; Bt = (const char*)Bt_; }
    __device__ __forceinline__ bool next(int i, Unit& u) const {
        const long L = (long)i * G + c; if (L >= nwg) return false;
        int wgid = (int)L; { const int q = nwg / NXCD, r = nwg % NXCD, xcd = wgid % NXCD, off = wgid / NXCD; wgid = (xcd < r ? xcd * (q + 1) : r * (q + 1) + (xcd - r) * q) + off; }
        const int nig = WGM * nN, gid = wgid / nig, fm = gid * WGM, gsz = (nM - fm) < WGM ? (nM - fm) : WGM;
        u.pm = fm + ((wgid % nig) % gsz); u.pn = (wgid % nig) / gsz; u.e = 0; u.mtl = 0; u.cnt = 0; return true;
    }
    __device__ __forceinline__ unsigned arow_off(const Unit& u, int rl) const { return (unsigned)(u.pm * BM + rl) * (unsigned)(KD * 2); }
    __device__ __forceinline__ const char* bbase(const Unit& u) const { return Bt + (size_t)u.pn * (size_t)(BM * KD * 2); }
};
template <int NPN, bool GATHER, int ROWB> struct MoeOrder {
    const LAS int* tp; const LAS int* cn; int G, vcu, lane; const int* list; const char* Bt; size_t bstride;
    __device__ __forceinline__ bool next(int i, Unit& u) const {
        const int L = i * G + vcu, chunk = L >> 5, s = L & 31;
        const int mt = (NPN == 8) ? chunk * 4 + (s & 3) : chunk * 8 + (s & 7), pn = (NPN == 8) ? (s >> 2) : (s >> 3);
        const int MT = tp[32];
        if (mt >= MT) return false;
        const int lj = lane < 1 ? 1 : (lane > 32 ? 32 : lane);
        const unsigned long long bm = __ballot(lane >= 1 && lane <= 32 && tp[lj] <= mt);
        const int e = __builtin_amdgcn_readfirstlane(__popcll(bm));
        u.pm = mt; u.pn = pn; u.e = e; u.mtl = __builtin_amdgcn_readfirstlane(mt - tp[e]); u.cnt = __builtin_amdgcn_readfirstlane(cn[e]); return true;
    }
    __device__ __forceinline__ unsigned arow_off(const Unit& u, int rl) const {
        if (GATHER) { int pos = u.mtl * BM + rl; pos = pos < u.cnt ? pos : u.cnt - 1; const int p = list[u.e * LISTCAP + pos]; return (unsigned)(p >> 2) * (unsigned)ROWB; }
        else return (unsigned)(u.pm * BM + rl) * (unsigned)ROWB;
    }
    __device__ __forceinline__ const char* bbase(const Unit& u) const { return Bt + (size_t)u.e * bstride + (size_t)u.pn * (size_t)(BM * ROWB); }
};

typedef int i32x4 __attribute__((ext_vector_type(4)));
typedef int i32x8 __attribute__((ext_vector_type(8)));
template <class Epi, class Sched, bool FP8 = false>
__device__ __forceinline__ void gemm_phase(LAS unsigned char* lds, const char* Abase, const Sched& S, const Epi& E) {
    const int tid = threadIdx.x, wid = __builtin_amdgcn_readfirstlane(tid >> 6), lane = tid & 63, wr = wid >> 2, wc = wid & 3, fr = lane & 15, fq = lane >> 4;
    constexpr int ROWB = FP8 ? KD : KD * 2, nt = ROWB / (BK * 2);
    int RA[2]; unsigned CA2[2], voffB[2];
#pragma unroll
    for (int i = 0; i < 2; ++i) { int R, C; stage_rc(tid * 16 + i * 8192, R, C); const int Rb = Epi::PERM ? ((R & ~31) + perm32(R & 31)) : R;
        RA[i] = R; CA2[i] = (unsigned)C * 2u; voffB[i] = (unsigned)(Rb * ROWB + C * 2); }
    constexpr size_t kstep = (size_t)(BK * 2);
    constexpr size_t hstep = (size_t)HALF * ROWB;
    const unsigned ldsw = (unsigned)wid * 1024u;
    const int aoff = lds_byte(wr * 64 + fr, fq * 8), boff = lds_byte(wc * 32 + fr, fq * 8);
#define PG8_SA(b, h) (((b) * 2 + (h)) * HTB)
#define PG8_SB(b, h) ((4 + (b) * 2 + (h)) * HTB)
#define PG8_STAGE_B(bufoff, gbase) do { _Pragma("unroll") for (int _i = 0; _i < 2; ++_i) \
        __builtin_amdgcn_global_load_lds((const unsigned*)((const char*)(gbase) + voffB[_i]), (LAS unsigned*)(lds + (bufoff) + ldsw + _i * 8192), 16, 0, 0); } while (0)
#define PG8_STAGE_A(bufoff, offs, kb) do { _Pragma("unroll") for (int _i = 0; _i < 2; ++_i) \
        __builtin_amdgcn_global_load_lds((const unsigned*)(Abase + (size_t)(offs)[_i] + (size_t)(kb)), (LAS unsigned*)(lds + (bufoff) + ldsw + _i * 8192), 16, 0, 0); } while (0)
#define PG8_LD8(p) __builtin_shufflevector(*(const LAS i32x4*)(p), *(const LAS i32x4*)((p) + 1024), 0, 1, 2, 3, 4, 5, 6, 7)
#define PG8_LDA(dst, b, h) do { _Pragma("unroll") for (int m = 0; m < 4; ++m) { if constexpr (FP8) dst##8[m] = PG8_LD8(lds + PG8_SA(b, h) + aoff + m * 2048); else { _Pragma("unroll") for (int k = 0; k < 2; ++k) dst[m][k] = *(const LAS bf16x8*)(lds + PG8_SA(b, h) + aoff + m * 2048 + k * 1024); } } } while (0)
#define PG8_LDB(dst, b, h) do { _Pragma("unroll") for (int n = 0; n < 2; ++n) { if constexpr (FP8) dst##8[n] = PG8_LD8(lds + PG8_SB(b, h) + boff + n * 2048); else { _Pragma("unroll") for (int k = 0; k < 2; ++k) dst[n][k] = *(const LAS bf16x8*)(lds + PG8_SB(b, h) + boff + n * 2048 + k * 1024); } } } while (0)
#define PG8_MMA(ai, bj, At, Bt) do { __builtin_amdgcn_s_setprio(1); _Pragma("unroll") for (int m = 0; m < 4; ++m) _Pragma("unroll") for (int n = 0; n < 2; ++n) { \
        if constexpr (FP8) asm volatile("s_nop 1\n\tv_mfma_f32_16x16x128_f8f6f4 %0, %1, %2, %0" : "+v"(acc[ai][bj][m][n]) : "v"(Bt##8[n]), "v"(At##8[m])); \
        else { _Pragma("unroll") for (int k = 0; k < 2; ++k) acc[ai][bj][m][n] = __builtin_amdgcn_mfma_f32_16x16x32_bf16(Bt[n][k], At[m][k], acc[ai][bj][m][n], 0, 0, 0); } } \
        __builtin_amdgcn_s_setprio(0); } while (0)
#define PG8_WAIT_V(n) asm volatile("s_waitcnt vmcnt(" #n ")" ::: "memory")
#define PG8_WAIT_L(n) asm volatile("s_waitcnt lgkmcnt(" #n ")" ::: "memory")
#define PG8_BAR __builtin_amdgcn_s_barrier()
#define PG8_SCHED __builtin_amdgcn_sched_barrier(0)
    Unit cur, nxt; int ui = 0;
    if (!S.next(0, cur)) return;
    f32x4 acc[2][2][4][2];
#pragma unroll
    for (int a = 0; a < 2; ++a)
#pragma unroll
        for (int b = 0; b < 2; ++b)
#pragma unroll
            for (int m = 0; m < 4; ++m)
#pragma unroll
                for (int n = 0; n < 2; ++n) { acc[a][b][m][n] = (f32x4){0.f, 0.f, 0.f, 0.f}; asm volatile("" : "+v"(acc[a][b][m][n])); }
    bf16x8 At[4][2], B0[2][2], B1[2][2];
    i32x8 At8[4], B08[2], B18[2];
    unsigned ao[2][2], no[2][2];
#pragma unroll
    for (int h = 0; h < 2; ++h)
#pragma unroll
        for (int i = 0; i < 2; ++i) ao[h][i] = S.arow_off(cur, h * HALF + RA[i]) + CA2[i];
    const char* cB = S.bbase(cur);
    PG8_STAGE_B(PG8_SB(0, 0), cB); PG8_STAGE_B(PG8_SB(0, 1), cB + hstep); PG8_STAGE_A(PG8_SA(0, 0), ao[0], 0); PG8_STAGE_A(PG8_SA(0, 1), ao[1], 0);
    if (wr == 1) PG8_BAR;
    PG8_WAIT_V(2); PG8_BAR;
    PG8_STAGE_B(PG8_SB(1, 0), cB + kstep); PG8_STAGE_A(PG8_SA(1, 0), ao[0], kstep); PG8_STAGE_B(PG8_SB(1, 1), cB + hstep + kstep);
    PG8_WAIT_V(6); PG8_BAR;
    for (;;) {
        const bool has_next = S.next(ui + 1, nxt);
        const char* nB = cB;
        if (has_next) {
#pragma unroll
            for (int h = 0; h < 2; ++h)
#pragma unroll
                for (int i = 0; i < 2; ++i) no[h][i] = S.arow_off(nxt, h * HALF + RA[i]) + CA2[i];
            nB = S.bbase(nxt);
        } else {
#pragma unroll
            for (int h = 0; h < 2; ++h)
#pragma unroll
                for (int i = 0; i < 2; ++i) no[h][i] = ao[h][i];
        }
#pragma nounroll
        for (int t = 0; t < nt; t += 2) {
            const bool last = (t == nt - 2);
            const size_t kb1 = (size_t)(t + 1) * kstep;
            unsigned s2[2][2];
#pragma unroll
            for (int h = 0; h < 2; ++h)
#pragma unroll
                for (int i = 0; i < 2; ++i) s2[h][i] = last ? no[h][i] : ao[h][i];
            const size_t kb2 = last ? 0 : (size_t)(t + 2) * kstep, kb3 = kb2 + kstep;
            const char* b2 = last ? nB : cB + (size_t)(t + 2) * kstep; const char* b3 = b2 + kstep;
            PG8_LDB(B0, 0, 0); PG8_LDB(B1, 0, 1); PG8_SCHED; PG8_LDA(At, 0, 0); PG8_STAGE_A(PG8_SA(1, 1), ao[1], kb1);
            PG8_WAIT_V(8); PG8_WAIT_L(0); PG8_BAR; PG8_MMA(0, 0, At, B0); PG8_MMA(0, 1, At, B1); PG8_BAR; PG8_SCHED;
            PG8_LDA(At, 0, 1); PG8_STAGE_B(PG8_SB(0, 0), b2); PG8_STAGE_B(PG8_SB(0, 1), b2 + hstep); PG8_STAGE_A(PG8_SA(0, 0), s2[0], kb2);
            PG8_WAIT_V(8); PG8_WAIT_L(0); PG8_BAR; PG8_MMA(1, 0, At, B0); PG8_MMA(1, 1, At, B1); PG8_BAR; PG8_SCHED;
            PG8_LDB(B0, 1, 0); PG8_LDB(B1, 1, 1); PG8_SCHED; PG8_LDA(At, 1, 0); PG8_STAGE_A(PG8_SA(0, 1), s2[1], kb2);
            PG8_WAIT_V(8); PG8_WAIT_L(0); PG8_BAR; PG8_MMA(0, 0, At, B0); PG8_MMA(0, 1, At, B1); PG8_BAR; PG8_SCHED;
            PG8_LDA(At, 1, 1); PG8_STAGE_B(PG8_SB(1, 0), b3); PG8_STAGE_B(PG8_SB(1, 1), b3 + hstep); PG8_STAGE_A(PG8_SA(1, 0), s2[0], kb3);
            PG8_WAIT_V(8); PG8_WAIT_L(0); PG8_BAR; PG8_MMA(1, 0, At, B0); PG8_MMA(1, 1, At, B1); PG8_BAR; PG8_SCHED;
        }
        if (wr == 0) PG8_BAR;
        if constexpr (FP8) asm volatile("s_nop 15\n\ts_nop 7" ::: "memory");
        E(acc, cur, wr, wc, fr, fq);
        if (!has_next) break;
#pragma unroll
        for (int a = 0; a < 2; ++a)
#pragma unroll
            for (int b = 0; b < 2; ++b)
#pragma unroll
                for (int m = 0; m < 4; ++m)
#pragma unroll
                    for (int n = 0; n < 2; ++n) { acc[a][b][m][n] = (f32x4){0.f, 0.f, 0.f, 0.f}; asm volatile("" : "+v"(acc[a][b][m][n])); }
        cur = nxt; cB = nB; ++ui;
#pragma unroll
        for (int h = 0; h < 2; ++h)
#pragma unroll
            for (int i = 0; i < 2; ++i) ao[h][i] = no[h][i];
        if (wr == 1) PG8_BAR;
    }
    PG8_WAIT_V(0);
    PG8_BAR;
#undef PG8_SA
#undef PG8_SB
#undef PG8_STAGE_A
#undef PG8_STAGE_B
#undef PG8_LDA
#undef PG8_LDB
#undef PG8_MMA
#undef PG8_LD8
#undef PG8_WAIT_V
#undef PG8_WAIT_L
#undef PG8_BAR
#undef PG8_SCHED
}

struct EpiIn {
    static constexpr bool PERM = true;
    bf16* Q; size_t qkv_stride;
    __device__ __forceinline__ void operator()(const f32x4 (&acc)[2][2][4][2], const Unit& u, int wr, int wc, int fr, int fq) const {
        const int row0 = u.pm * BM + wr * 64 + fr; bf16* HG = Q + 3 * qkv_stride;
        if (u.pn < 6) {
            bf16* base = Q + (size_t)(u.pn >> 1) * qkv_stride; const float sc = u.pn < 2 ? QSCALE : 1.0f;
            const int col0 = (u.pn & 1) * 256 + wc * 32 + 8 * fq;
#pragma unroll
            for (int ai = 0; ai < 2; ++ai)
#pragma unroll
                for (int m = 0; m < 4; ++m) { bf16* rowp = base + (size_t)(row0 + ai * HALF + m * 16) * AW + col0;
#pragma unroll
                    for (int bj = 0; bj < 2; ++bj) { const f32x4 v0 = acc[ai][bj][m][0] * sc, v1 = acc[ai][bj][m][1] * sc;
                        u32x4 w; w.x = cvt_pk_bf16(v0[0], v0[1]); w.y = cvt_pk_bf16(v0[2], v0[3]); w.z = cvt_pk_bf16(v1[0], v1[1]); w.w = cvt_pk_bf16(v1[2], v1[3]);
                        *(u32x4*)(rowp + bj * HALF) = w; } }
        } else {
            const int col0 = (u.pn - 6) * 128 + wc * 32 + 8 * fq;
#pragma unroll
            for (int ai = 0; ai < 2; ++ai)
#pragma unroll
                for (int m = 0; m < 4; ++m) { bf16* rowp = HG + (size_t)(row0 + ai * HALF + m * 16) * AW + col0;
                    float o[8];
#pragma unroll
                    for (int n = 0; n < 2; ++n)
#pragma unroll
                        for (int j = 0; j < 4; ++j) o[n * 4 + j] = acc[ai][0][m][n][j] * sigmoidf_(acc[ai][1][m][n][j]);
                    u32x4 w; w.x = cvt_pk_bf16(o[0], o[1]); w.y = cvt_pk_bf16(o[2], o[3]); w.z = cvt_pk_bf16(o[4], o[5]); w.w = cvt_pk_bf16(o[6], o[7]);
                    *(u32x4*)rowp = w; }
        }
    }
};
struct EpiOut {
    static constexpr bool PERM = false;
    float* Y1; const bf16* XN;
    __device__ __forceinline__ void operator()(const f32x4 (&acc)[2][2][4][2], const Unit& u, int wr, int wc, int fr, int fq) const {
        const int row0 = u.pm * BM + wr * 64 + fr, col0 = u.pn * BM + wc * 32 + 4 * fq;
#pragma unroll
        for (int ai = 0; ai < 2; ++ai)
#pragma unroll
            for (int m = 0; m < 4; ++m) { const size_t ro = (size_t)(row0 + ai * HALF + m * 16) * DM + col0;
#pragma unroll
                for (int bj = 0; bj < 2; ++bj)
#pragma unroll
                    for (int n = 0; n < 2; ++n) { const u32x2 xw = *(const u32x2*)(XN + ro + bj * HALF + n * 16);
                        f32x4 o = acc[ai][bj][m][n]; o[0] += ALPHA * bf_lo(xw.x); o[1] += ALPHA * bf_hi(xw.x); o[2] += ALPHA * bf_lo(xw.y); o[3] += ALPHA * bf_hi(xw.y);
                        *(f32x4*)(Y1 + ro + bj * HALF + n * 16) = o; } }
    }
};
struct EpiSwiglu {
    static constexpr bool PERM = true;
    unsigned char* HID; const float* bgu;
    __device__ __forceinline__ void operator()(const f32x4 (&acc)[2][2][4][2], const Unit& u, int wr, int wc, int fr, int fq) const {
        const int row0 = u.pm * BM + wr * 64 + fr, ch0 = u.pn * 128 + wc * 32 + 8 * fq; constexpr float ISC = 1.0f / (SX8 * SW8);
        const float* bg = bgu + (size_t)u.e * 2048 + ch0; const float* bu = bg + 1024;
        f32x4 bgv[2], buv[2];
#pragma unroll
        for (int n = 0; n < 2; ++n) { bgv[n] = *(const f32x4*)(bg + 4 * n); buv[n] = *(const f32x4*)(bu + 4 * n); }
#pragma unroll
        for (int ai = 0; ai < 2; ++ai)
#pragma unroll
            for (int m = 0; m < 4; ++m) { unsigned char* rowp = HID + (size_t)(row0 + ai * HALF + m * 16) * DFF + ch0;
                float o[8];
#pragma unroll
                for (int n = 0; n < 2; ++n)
#pragma unroll
                    for (int j = 0; j < 4; ++j) { float g = acc[ai][0][m][n][j] * ISC + bgv[n][j], up = acc[ai][1][m][n][j] * ISC + buv[n][j];
                        g = fminf(g, 7.0f); up = fminf(fmaxf(up, -7.0f), 7.0f);
                        o[n * 4 + j] = g * sigmoidf_(1.702f * g) * (up + 1.0f) * SH8; }
                u32x2 w; w.x = pk4_fp8(o[0], o[1], o[2], o[3]); w.y = pk4_fp8(o[4], o[5], o[6], o[7]);
                *(u32x2*)rowp = w; }
    }
};
struct EpiDown {
    static constexpr bool PERM = true;
    bf16* YP; const float* bd; const int* list; const float* gatew;
    __device__ __forceinline__ void operator()(const f32x4 (&acc)[2][2][4][2], const Unit& u, int wr, int wc, int fr, int fq) const {
        const int rl0 = wr * 64 + fr, col0 = u.pn * BM + wc * 32 + 8 * fq;
        f32x4 bv[2][2];
#pragma unroll
        for (int bj = 0; bj < 2; ++bj)
#pragma unroll
            for (int n = 0; n < 2; ++n) bv[bj][n] = *(const f32x4*)(bd + (size_t)u.e * DM + col0 + bj * HALF + 4 * n);
#pragma unroll
        for (int ai = 0; ai < 2; ++ai)
#pragma unroll
            for (int m = 0; m < 4; ++m) { const int pos = u.mtl * BM + rl0 + ai * HALF + m * 16;
                if (pos < u.cnt) { const int p = list[u.e * LISTCAP + pos]; const float gw = gatew[p]; bf16* rowp = YP + (size_t)p * DM + col0;
#pragma unroll
                    for (int bj = 0; bj < 2; ++bj) { constexpr float ISC = 1.0f / (SH8 * SW8); const f32x4 v0 = (acc[ai][bj][m][0] * ISC + bv[bj][0]) * gw, v1 = (acc[ai][bj][m][1] * ISC + bv[bj][1]) * gw;
                        u32x4 w; w.x = cvt_pk_bf16(v0[0], v0[1]); w.y = cvt_pk_bf16(v0[2], v0[3]); w.z = cvt_pk_bf16(v1[0], v1[1]); w.w = cvt_pk_bf16(v1[2], v1[3]);
                        *(u32x4*)(rowp + bj * HALF) = w; } } }
    }
};
}

#define XB_TMO      128
#define XB_XCNT(j)  (256  + 64 * (j))
#define XB_XSUB(j)  (1280 + 64 * (j))
#define XB_XGEN(j)  (2304 + 64 * (j))
#define XB_TOP      3328
#define XB_TOPGEN   3392
#define XCD_BAR_WORDS 3456
#define XB_SPIN_CAP (1u << 18)
__device__ __forceinline__ unsigned xb_ld(unsigned* p)              { return __hip_atomic_load(p, __ATOMIC_RELAXED, __HIP_MEMORY_SCOPE_AGENT); }
__device__ __forceinline__ unsigned xb_add(unsigned* p, unsigned v) { return __hip_atomic_fetch_add(p, v, __ATOMIC_RELAXED, __HIP_MEMORY_SCOPE_AGENT); }
__device__ __forceinline__ unsigned xb_xcc_id() { return (unsigned)__builtin_amdgcn_s_getreg((3 << 11) | 20) & 0xFu; }
#define XB_SPIN(cond, bar) do { unsigned _sp = 0; while (cond) { __builtin_amdgcn_s_sleep(1); \
    if ((++_sp & 255u) == 0u) { if (xb_ld(&(bar)[XB_TMO])) break; if (_sp > XB_SPIN_CAP) { atomicAdd(&(bar)[XB_TMO], 1u); break; } } } } while (0)
struct XcdBarrier { unsigned* bar; unsigned x; volatile LAS unsigned* st; };
__device__ __forceinline__ XcdBarrier xcd_barrier_post(unsigned* bar, volatile LAS unsigned* st) {
    XcdBarrier b; b.bar = bar; b.x = xb_xcc_id(); b.st = st;
    if (threadIdx.x == 0) (void)xb_add(&bar[XB_XCNT(b.x)], 1u);
    return b;
}
__device__ __forceinline__ void xcd_barrier_complete(unsigned* bar, unsigned x, unsigned& nloc, unsigned& nx) {
    const unsigned G = gridDim.x * gridDim.y * gridDim.z;
    unsigned sum, cnt, mine, sp = 0u;
    for (;;) {
        sum = 0u; cnt = 0u; mine = 0u;
#pragma unroll
        for (unsigned j = 0; j < 16; ++j) { const unsigned c = xb_ld(&bar[XB_XCNT(j)]); sum += c; cnt += (c > 0u) ? 1u : 0u; mine = (j == x) ? c : mine; }
        if (sum == G) break;
        __builtin_amdgcn_s_sleep(1);
        if ((++sp & 255u) == 0u) { if (xb_ld(&bar[XB_TMO])) break; if (sp > XB_SPIN_CAP) { atomicAdd(&bar[XB_TMO], 1u); break; } }
    }
    nloc = mine > 0u ? mine : 1u; nx = cnt > 0u ? cnt : 1u;
}
__device__ __forceinline__ void xcd_barrier(const XcdBarrier& b) {
    asm volatile("s_waitcnt vmcnt(0)" ::: "memory");
    __syncthreads();
    if (threadIdx.x == 0) {
        unsigned* bar = b.bar;
        __builtin_amdgcn_s_waitcnt(0);
        unsigned nloc = b.st[0], nx = b.st[1];
        if (nloc == 0u) { xcd_barrier_complete(bar, b.x, nloc, nx); b.st[0] = nloc; b.st[1] = nx; }
        const unsigned old = xb_add(&bar[XB_XSUB(b.x)], 1u);
        const unsigned gen = old / nloc;
        if (old + 1u == (gen + 1u) * nloc) {
            __builtin_amdgcn_fence(__ATOMIC_RELEASE, "agent");
            asm volatile("s_waitcnt vmcnt(0)" ::: "memory");
            const unsigned og = xb_add(&bar[XB_TOP], 1u);
            const unsigned tg = og / nx;
            if (og + 1u == (tg + 1u) * nx) xb_add(&bar[XB_TOPGEN], 1u);
            else XB_SPIN(xb_ld(&bar[XB_TOPGEN]) == tg, bar);
            __builtin_amdgcn_fence(__ATOMIC_ACQUIRE, "agent");
            xb_add(&bar[XB_XGEN(b.x)], 1u);
            asm volatile("s_waitcnt vmcnt(0)" ::: "memory");
        } else {
            XB_SPIN(xb_ld(&bar[XB_XGEN(b.x)]) == gen, bar);
            __builtin_amdgcn_fence(__ATOMIC_ACQUIRE, "agent");
            asm volatile("s_waitcnt vmcnt(0)" ::: "memory");
        }
    }
    __syncthreads();
}

struct Frame {
    LAS unsigned char* lds; volatile LAS unsigned* MISC; gu32* ctl;
    int tid, lane, wave, vcu, G;
};
struct Args { const float* in[24]; float* out; unsigned char* ws; int ph_lo, ph_hi; };

__device__ __forceinline__ void p0_transpose_item(const float* W, int K, int N, bf16* WT, int k0, int n0, int drow0, LAS float* scr, int lane) {
#pragma unroll 8
    for (int i = 0; i < 32; ++i) { const int kk = 2 * i + (lane >> 5); scr[kk * 33 + (lane & 31)] = W[(size_t)(k0 + kk) * N + n0 + (lane & 31)]; }
    LDS_WAIT(); asm volatile("" ::: "memory");
    const int c = lane & 7;
#pragma unroll
    for (int j = 0; j < 4; ++j) { const int n = (lane >> 3) + 8 * j; const LAS float* s = scr + (8 * c) * 33 + n;
        u32x4 o; o.x = cvt_pk_bf16(s[0 * 33], s[1 * 33]); o.y = cvt_pk_bf16(s[2 * 33], s[3 * 33]); o.z = cvt_pk_bf16(s[4 * 33], s[5 * 33]); o.w = cvt_pk_bf16(s[6 * 33], s[7 * 33]);
        *(GAS u32x4*)(WT + (size_t)(drow0 + n) * K + k0 + 8 * c) = o; }
    LDS_WAIT(); asm volatile("" ::: "memory");
}
__device__ __forceinline__ void p0_transpose_item_fp8(const float* W, int K, int N, unsigned char* WT8, int k0, int n0, int drow0, LAS float* scr, int lane, float scale) {
#pragma unroll 8
    for (int i = 0; i < 32; ++i) { const int kk = 2 * i + (lane >> 5); scr[kk * 33 + (lane & 31)] = W[(size_t)(k0 + kk) * N + n0 + (lane & 31)]; }
    LDS_WAIT(); asm volatile("" ::: "memory");
    const int c = lane & 7;
#pragma unroll
    for (int j = 0; j < 4; ++j) { const int n = (lane >> 3) + 8 * j; const LAS float* s = scr + (8 * c) * 33 + n;
        u32x2 o; o.x = pk4_fp8(s[0 * 33] * scale, s[1 * 33] * scale, s[2 * 33] * scale, s[3 * 33] * scale); o.y = pk4_fp8(s[4 * 33] * scale, s[5 * 33] * scale, s[6 * 33] * scale, s[7 * 33] * scale);
        *(GAS u32x2*)(WT8 + (size_t)(drow0 + n) * K + k0 + 8 * c) = o; }
    LDS_WAIT(); asm volatile("" ::: "memory");
}
__device__ __forceinline__ void ln_row_to_bf16(const float* xrow, const float* g, const float* b, bf16* orow, int lane) {
    const GAS f32x4* xr = (const GAS f32x4*)xrow + lane;
    f32x4 v[4]; float s = 0.f;
#pragma unroll
    for (int j = 0; j < 4; ++j) { v[j] = xr[64 * j]; s += (v[j].x + v[j].y) + (v[j].z + v[j].w); }
    const float mean = wave_sum(s) * (1.f / DM); float s2 = 0.f;
#pragma unroll
    for (int j = 0; j < 4; ++j) { v[j] = v[j] - mean; s2 += (v[j].x * v[j].x + v[j].y * v[j].y) + (v[j].z * v[j].z + v[j].w * v[j].w); }
    const float rstd = 1.f / sqrtf(wave_sum(s2) * (1.f / DM) + LN_EPS);
    GAS u32x2* o8 = (GAS u32x2*)orow + lane;
#pragma unroll
    for (int j = 0; j < 4; ++j) { const f32x4 gg = *((const GAS f32x4*)g + lane + 64 * j), bb = *((const GAS f32x4*)b + lane + 64 * j);
        const f32x4 y = v[j] * rstd * gg + bb; u32x2 w; w.x = cvt_pk_bf16(y.x, y.y); w.y = cvt_pk_bf16(y.z, y.w); o8[64 * j] = w; }
}

namespace att {
constexpr int STG = 32768;
constexpr int LDS_WS = LDSCTL_OFF + 2048;
__device__ __forceinline__ void glds16(const void* gsrc, unsigned lds_dst) { unsigned keep;
    asm volatile("s_mov_b32 %0, m0\n\ts_mov_b32 m0, %2\n\ts_nop 0\n\tglobal_load_lds_dwordx4 %1, off\n\ts_mov_b32 m0, %0" : "=&s"(keep) : "v"(gsrc), "s"(lds_dst) : "memory"); }
__device__ __forceinline__ int crow(int r, int hi) { return (r & 3) + 8 * (r >> 2) + 4 * hi; }
__device__ __forceinline__ float swapmax(float m) { auto rr = __builtin_amdgcn_permlane32_swap(__float_as_uint(m), __float_as_uint(m), false, false); return fmaxf(__uint_as_float(rr[0]), __uint_as_float(rr[1])); }
__device__ __forceinline__ float swapsum(float m) { auto rr = __builtin_amdgcn_permlane32_swap(__float_as_uint(m), __float_as_uint(m), false, false); return __uint_as_float(rr[0]) + __uint_as_float(rr[1]); }
__device__ __forceinline__ s16x4 vtr(const LAS unsigned char* p) { typedef short v4i16_t __attribute__((ext_vector_type(4))); return __builtin_bit_cast(s16x4, __builtin_amdgcn_ds_read_tr16_b64_v4i16((LAS v4i16_t*)p)); }
}

__global__ void __launch_bounds__(NWAVES * 64, 2) hymba_fwd(Args args) {
    extern __shared__ __attribute__((aligned(16))) unsigned char lds_raw[];
    Frame F;
    F.lds = (LAS unsigned char*)lds_raw;
    F.MISC = (volatile LAS unsigned*)(F.lds + MISC_OFF);
    F.tid = threadIdx.x; F.lane = F.tid & 63; F.wave = __builtin_amdgcn_readfirstlane(F.tid >> 6);
    F.G = gridDim.x; { const int bx = blockIdx.x; F.vcu = (F.G % 8 == 0) ? (bx % 8) * (F.G / 8) + bx / 8 : bx; }
    unsigned char* ws = args.ws;
    F.ctl = (gu32*)(ws + WS_CTL);
    for (int u = F.tid; u < (LDS_BYTES - LDSCTL_OFF) / 4; u += NWAVES * 64) ((LAS unsigned*)(F.lds + LDSCTL_OFF))[u] = 0u;
    __syncthreads();
    XcdBarrier bar; bar.bar = (unsigned*)(F.ctl + CW_BAR); bar.x = 0; bar.st = nullptr;
    if (MK_N_LAUNCHES == 1) bar = xcd_barrier_post((unsigned*)(F.ctl + CW_BAR), F.MISC + 8);
    const int lo = args.ph_lo, hi = args.ph_hi;
#ifndef PH_MASK
#define PH_MASK 0xff
#endif
#define IN(k) (((PH_MASK >> (k)) & 1) && lo <= (k) && (k) < hi)
#define BOTH(k) (IN(k) && IN((k) + 1))
#ifndef REP_MASK
#define REP_MASK 0
#endif
#define NREP(k) (((REP_MASK >> (k)) & 1) ? 2 : 1)
#define GRID_BAR() do { xcd_barrier(bar); } while (0)
    const int lane = F.lane, wave = F.wave, tid = F.tid;
    const int gw = F.vcu * NWAVES + wave, NGW = F.G * NWAVES;

    const float* x_in = args.in[0];
    bf16* Win_t = (bf16*)(ws + WS_WIN); bf16* Wout_t = (bf16*)(ws + WS_WOUT); unsigned char* Wgu_t = ws + WS_WGU; unsigned char* Wd_t = ws + WS_WD;
    bf16* XN = (bf16*)(ws + WS_XN); bf16* Qb = (bf16*)(ws + WS_Q); bf16* Kb = (bf16*)(ws + WS_K); bf16* Vb = (bf16*)(ws + WS_V); bf16* HG = (bf16*)(ws + WS_HG);
    bf16* AC = (bf16*)(ws + WS_AC); float* Y1 = (float*)(ws + WS_Y1); bf16* X1 = (bf16*)(ws + WS_X1); unsigned char* HID = ws + WS_HID; bf16* YP = (bf16*)(ws + WS_YP); unsigned char* X1Q = ws + WS_X1Q;
    int* LIST = (int*)(ws + WS_LIST); float* GATEW = (float*)(ws + WS_GATE);

    if (IN(0)) {
      for (int rep_ = 0; rep_ < NREP(0); ++rep_) {
        LAS float* scr = (LAS float*)(F.lds + RING_OFF + wave * 16384);
        constexpr int I_IN = 16 * (IN_COLS / 32), I_OUT = 16 * 32, I_GU = 16 * 64, I_D = 16 * 32;
        constexpr int NITEMS = I_IN + I_OUT + NEXP * I_GU + NEXP * I_D;
        struct TItem { const float* W; unsigned char* dst; int N, k0, n0, drow0, fp8; };
        auto decode = [&](int it) -> TItem {
            TItem ti; int r = it;
            if (r < I_IN) { const int nblk = IN_COLS / 32, kb = r / nblk, nb = r % nblk, n0 = 32 * nb; int d;
                if (n0 < 1536) d = n0; else { const int j = n0 - 1536, g = j >= 512, ch = j & 511; d = 1536 + (ch >> 7) * 256 + g * 128 + (ch & 127); }
                ti.W = args.in[3]; ti.dst = (unsigned char*)Win_t; ti.N = IN_COLS; ti.k0 = 64 * kb; ti.n0 = n0; ti.drow0 = d; ti.fp8 = 0; return ti; }
            r -= I_IN;
            if (r < I_OUT) { const int kb = r / 32, nb = r % 32; ti.W = args.in[13]; ti.dst = (unsigned char*)Wout_t; ti.N = DM; ti.k0 = 64 * kb; ti.n0 = 32 * nb; ti.drow0 = 32 * nb; ti.fp8 = 0; return ti; }
            r -= I_OUT;
            if (r < NEXP * I_GU) { const int e = r / I_GU, q = r % I_GU, kb = q / 64, nb = q % 64, n0 = 32 * nb, g = n0 >= 1024, ch = n0 & 1023, d = (ch >> 7) * 256 + g * 128 + (ch & 127);
                ti.W = args.in[18] + (size_t)e * DM * 2048; ti.dst = Wgu_t + (size_t)e * 2048 * DM; ti.N = 2048; ti.k0 = 64 * kb; ti.n0 = n0; ti.drow0 = d; ti.fp8 = 1; return ti; }
            r -= NEXP * I_GU;
            { const int e = r / I_D, q = r % I_D, kb = q / 32, nb = q % 32;
                ti.W = args.in[20] + (size_t)e * DFF * DM; ti.dst = Wd_t + (size_t)e * DM * DFF; ti.N = DM; ti.k0 = 64 * kb; ti.n0 = 32 * nb; ti.drow0 = 32 * nb; ti.fp8 = 1; return ti; }
        };
        const int kr = lane >> 3, c4 = lane & 7;
        f32x4 tv[8], tn[8];
        TItem cur_i, nxt_i;
        int it = gw;
        if (it < NITEMS) { cur_i = decode(it);
#pragma unroll
            for (int i = 0; i < 8; ++i) tv[i] = *(const GAS f32x4*)(cur_i.W + (size_t)(cur_i.k0 + kr + 8 * i) * cur_i.N + cur_i.n0 + 4 * c4); }
        for (; it < NITEMS; it += NGW) {
            const bool has_n = it + NGW < NITEMS;
            if (has_n) { nxt_i = decode(it + NGW);
#pragma unroll
                for (int i = 0; i < 8; ++i) tn[i] = *(const GAS f32x4*)(nxt_i.W + (size_t)(nxt_i.k0 + kr + 8 * i) * nxt_i.N + nxt_i.n0 + 4 * c4); }
#pragma unroll
            for (int i = 0; i < 8; ++i) { LAS float* sp = scr + (kr + 8 * i) * 33 + 4 * c4; sp[0] = tv[i][0]; sp[1] = tv[i][1]; sp[2] = tv[i][2]; sp[3] = tv[i][3]; }
            LDS_WAIT(); asm volatile("" ::: "memory");
            { const int c = lane & 7;
#pragma unroll
              for (int j = 0; j < 4; ++j) { const int n = (lane >> 3) + 8 * j; const LAS float* sq = scr + (8 * c) * 33 + n;
                  if (cur_i.fp8) { u32x2 o; o.x = pk4_fp8(sq[0 * 33] * SW8, sq[1 * 33] * SW8, sq[2 * 33] * SW8, sq[3 * 33] * SW8); o.y = pk4_fp8(sq[4 * 33] * SW8, sq[5 * 33] * SW8, sq[6 * 33] * SW8, sq[7 * 33] * SW8);
                      *(GAS u32x2*)(cur_i.dst + (size_t)(cur_i.drow0 + n) * DM + cur_i.k0 + 8 * c) = o; }
                  else { u32x4 o; o.x = cvt_pk_bf16(sq[0 * 33], sq[1 * 33]); o.y = cvt_pk_bf16(sq[2 * 33], sq[3 * 33]); o.z = cvt_pk_bf16(sq[4 * 33], sq[5 * 33]); o.w = cvt_pk_bf16(sq[6 * 33], sq[7 * 33]);
                      *(GAS u32x4*)((bf16*)cur_i.dst + (size_t)(cur_i.drow0 + n) * DM + cur_i.k0 + 8 * c) = o; } } }
            LDS_WAIT(); asm volatile("" ::: "memory");
            if (has_n) { cur_i = nxt_i;
#pragma unroll
                for (int i = 0; i < 8; ++i) tv[i] = tn[i]; }
        }
        for (int m = gw; m < NTOK; m += NGW) ln_row_to_bf16(x_in + (size_t)m * DM, args.in[1], args.in[2], XN + (size_t)m * DM, lane);
        __syncthreads();
      }
        if (BOTH(0)) GRID_BAR();
    }

    if (IN(1)) {
        pg8::DenseOrder S; S.init(NTOK, IN_COLS, F.G, (int)blockIdx.x, Win_t);
        static_assert(WS_K - WS_Q == WS_V - WS_K && WS_HG - WS_V == WS_K - WS_Q, "Q|K|V|HG equally spaced");
        pg8::EpiIn E{Qb, (size_t)(WS_K - WS_Q) / 2};
        pg8::gemm_phase<pg8::EpiIn, pg8::DenseOrder>(F.lds + RING_OFF, (const char*)XN, S, E);
        if (NREP(1) == 2) { pg8::gemm_phase<pg8::EpiIn, pg8::DenseOrder>(F.lds + RING_OFF, (const char*)XN, S, E); }
        if (BOTH(1)) GRID_BAR();
    }

    if (IN(2)) {
        using namespace att;
      for (int rep_ = 0; rep_ < NREP(2); ++rep_) {
#ifndef NO_ATTN
        for (int rep8_ = 0; rep8_ < NREP(8); ++rep8_)
        for (int un = F.vcu; un < 256; un += F.G)
        for (int ui = 0; ui < 2; ++ui) {
            const int bh = un >> 3, jj = un & 7, j = ui == 0 ? 15 - jj : jj, b = bh >> 2, h = bh & 3;
            const int r32 = lane & 31, hi = lane >> 5;
            const int comp = wave >> 2, qi = wave & 3;
            const int p = 4 * j + qi;
            const int dt = p >> 1;
            const int T = 2 * j + 2;
            const size_t rowbase = (size_t)b * SEQ;
            const int q = 32 * p + r32;
            const float sl2 = LOG2E * (h == 0 ? 0.25f : h == 1 ? 0.0625f : h == 2 ? 0.015625f : 0.00390625f);
            bf16x8 qr[4];
#pragma unroll
            for (int d0 = 0; d0 < 4; ++d0) qr[d0] = *(const bf16x8*)(Qb + (rowbase + 32 * p + r32) * AW + h * 128 + comp * 64 + d0 * 16 + hi * 8);
            f32x16 o[4];
#pragma unroll
            for (int db = 0; db < 4; ++db)
#pragma unroll
                for (int r = 0; r < 16; ++r) o[db][r] = 0.f;
            float mrun = -INFINITY, lrun = 0.f;
            LAS float* wsf = (LAS float*)(F.lds + LDS_WS) + wave * 128;
            unsigned ksrc[2], vsrc[2];
#pragma unroll
            for (int i = 0; i < 2; ++i) { const int pc = 2 * wave + i; ksrc[i] = (unsigned)((rowbase + lane) * AW + h * 128 + pc * 8);
                vsrc[i] = (unsigned)((rowbase + (pc & 3) * 16 + (lane >> 2)) * AW + h * 128 + (pc >> 2) * 32 + (lane & 3) * 8); }
            const unsigned ldsb = (unsigned)(size_t)(F.lds + RING_OFF) + (unsigned)(2 * wave) * 1024u;
#define ATT_ISSUE(t, st) do { _Pragma("unroll") for (int _i = 0; _i < 2; ++_i) { \
                glds16(Kb + ksrc[_i] + (size_t)(t) * 64 * AW, (unsigned)__builtin_amdgcn_readfirstlane(ldsb + (st) * STG + _i * 1024)); \
                glds16(Vb + vsrc[_i] + (size_t)(t) * 64 * AW, (unsigned)__builtin_amdgcn_readfirstlane(ldsb + (st) * STG + 16384 + _i * 1024)); } } while (0)
#pragma unroll
            for (int d0 = 0; d0 < 4; ++d0) asm volatile("" : "+v"(qr[d0]));
            ATT_ISSUE(T - 1, 0);
            if (T >= 2) ATT_ISSUE(T - 2, 1);
            int st = 0, st2 = 2;
            const int vlane = ((lane >> 4) & 1) * 32 + (lane & 3) * 8 + (4 * hi + ((lane & 15) >> 2)) * 64;
            for (int it = 0; it < T; ++it) {
                const int t = T - 1 - it;
                if (it + 1 < T) asm volatile("s_waitcnt vmcnt(4)" ::: "memory"); else asm volatile("s_waitcnt vmcnt(0)" ::: "memory");
                asm volatile("s_waitcnt lgkmcnt(0)\n\ts_barrier" ::: "memory");
                if (it + 2 < T) ATT_ISSUE(t - 2, st2);
                if (t <= dt) {
                    const LAS unsigned char* Ks = F.lds + RING_OFF + st * STG;
                    const LAS unsigned char* Vs = Ks + 16384;
                    bf16x8 kf[8]; s16x4 vA[16], vB[16];
#pragma unroll
                    for (int d0 = 0; d0 < 4; ++d0) { const LAS unsigned char* kb = Ks + (comp * 8 + 2 * d0 + hi) * 1024 + r32 * 16; kf[2 * d0] = *(const LAS bf16x8*)kb; kf[2 * d0 + 1] = *(const LAS bf16x8*)(kb + 512); }
#pragma unroll
                    for (int i = 0; i < 8; ++i) { const LAS unsigned char* vp = Vs + i * 1024 + vlane; vA[2 * i] = vtr(vp); vA[2 * i + 1] = vtr(vp + 512); }
                    __builtin_amdgcn_sched_barrier(0);
                    float sl2v = sl2; asm volatile("" : "+v"(sl2v));
                    const float fb = sl2v * (float)(64 * t + 4 * hi - q);
                    f32x16 p0, p1;
#pragma unroll
                    for (int r = 0; r < 16; ++r) { p0[r] = fb + sl2v * (float)((r & 3) + 8 * (r >> 2)); p1[r] = p0[r] + 32.0f * sl2v; }
#pragma unroll
                    for (int d0 = 0; d0 < 4; ++d0) {
                        p0 = __builtin_amdgcn_mfma_f32_32x32x16_bf16(kf[2 * d0], qr[d0], p0, 0, 0, 0);
                        p1 = __builtin_amdgcn_mfma_f32_32x32x16_bf16(kf[2 * d0 + 1], qr[d0], p1, 0, 0, 0);
                    }
                    __builtin_amdgcn_sched_barrier(0);
#pragma unroll
                    for (int i = 0; i < 8; ++i) { const LAS unsigned char* vp = Vs + (8 + i) * 1024 + vlane; vB[2 * i] = vtr(vp); vB[2 * i + 1] = vtr(vp + 512); }
                    __builtin_amdgcn_sched_barrier(0);
                    if (t == dt) {
                        const int kb0 = 64 * t + 4 * hi - q;
#pragma unroll
                        for (int r = 0; r < 16; ++r) { const int rel = kb0 + (r & 3) + 8 * (r >> 2); if (rel > 0) p0[r] = -INFINITY; if (rel + 32 > 0) p1[r] = -INFINITY; }
                    }
                    float rm = fmaxf(p0[0], p1[0]);
#pragma unroll
                    for (int r = 1; r < 16; ++r) rm = fmaxf(rm, fmaxf(p0[r], p1[r]));
                    rm = swapmax(rm);
                    const float mn = fmaxf(mrun, rm);
                    if (__any(rm > mrun + 8.0f)) {
                        const float f = fast_exp2(mrun - mn);
                        lrun *= f; mrun = mn;
                        if (hi == 0) wsf[r32] = f;
                        LDS_WAIT();
#pragma unroll
                        for (int r = 0; r < 16; ++r) { const float fr_ = wsf[crow(r, hi)];
#pragma unroll
                            for (int db = 0; db < 4; ++db) o[db][r] *= fr_; }
                        LDS_WAIT();
                    }
                    float ls = 0.f;
#pragma unroll
                    for (int r = 0; r < 16; ++r) { p0[r] = fast_exp2(p0[r] - mrun); p1[r] = fast_exp2(p1[r] - mrun); ls += p0[r] + p1[r]; }
                    lrun += ls;
                    bf16x8 pa[4];
                    { u32x4 w0, w1, w2, w3;
                    w0.x = cvt_pk_bf16(p0[0], p0[1]); w0.y = cvt_pk_bf16(p0[2], p0[3]); w0.z = cvt_pk_bf16(p0[4], p0[5]); w0.w = cvt_pk_bf16(p0[6], p0[7]);
                    w1.x = cvt_pk_bf16(p0[8], p0[9]); w1.y = cvt_pk_bf16(p0[10], p0[11]); w1.z = cvt_pk_bf16(p0[12], p0[13]); w1.w = cvt_pk_bf16(p0[14], p0[15]);
                    w2.x = cvt_pk_bf16(p1[0], p1[1]); w2.y = cvt_pk_bf16(p1[2], p1[3]); w2.z = cvt_pk_bf16(p1[4], p1[5]); w2.w = cvt_pk_bf16(p1[6], p1[7]);
                    w3.x = cvt_pk_bf16(p1[8], p1[9]); w3.y = cvt_pk_bf16(p1[10], p1[11]); w3.z = cvt_pk_bf16(p1[12], p1[13]); w3.w = cvt_pk_bf16(p1[14], p1[15]);
                    pa[0] = __builtin_bit_cast(bf16x8, w0); pa[1] = __builtin_bit_cast(bf16x8, w1); pa[2] = __builtin_bit_cast(bf16x8, w2); pa[3] = __builtin_bit_cast(bf16x8, w3); }
                    __builtin_amdgcn_sched_barrier(0);
#pragma unroll
                    for (int db = 0; db < 4; ++db)
#pragma unroll
                        for (int ks = 0; ks < 4; ++ks) {
                            const int i = (db & 1) * 4 + ks;
                            const s16x4 vl = db < 2 ? vA[2 * i] : vB[2 * i], vh = db < 2 ? vA[2 * i + 1] : vB[2 * i + 1];
                            const bf16x8 vf = (bf16x8){vl[0], vl[1], vl[2], vl[3], vh[0], vh[1], vh[2], vh[3]};
                            o[db] = __builtin_amdgcn_mfma_f32_32x32x16_bf16(pa[ks], vf, o[db], 0, 0, 0);
                        }
                }
                st = (st == 2) ? 0 : st + 1; st2 = (st2 == 2) ? 0 : st2 + 1;
            }
#undef ATT_ISSUE
            asm volatile("s_waitcnt lgkmcnt(0)\n\ts_barrier" ::: "memory");
            {
                int lane_o = lane; asm volatile("" : "+v"(lane_o));
                const int r32o = lane_o & 31, hio = lane_o >> 5;
                LAS float* wsf2 = (LAS float*)(F.lds + LDS_WS) + wave * 128;
                LAS float* XB = (LAS float*)(F.lds + RING_OFF) + qi * 4096 + lane_o;
                const float linv = fast_rcp(swapsum(lrun));
                if (comp == 1) {
                    float lam;
                    { const float a = args.in[4][lane_o] * args.in[5][lane_o], bb2 = args.in[6][lane_o] * args.in[7][lane_o];
                      lam = __expf(wave_sum(a)) - __expf(wave_sum(bb2)) + LAMBDA_INIT; }
                    if (hio == 0) wsf2[r32o] = lam * linv;
                    LDS_WAIT();
#pragma unroll
                    for (int r = 0; r < 16; ++r) { const float a1 = wsf2[crow(r, hio)];
#pragma unroll
                        for (int db = 0; db < 4; ++db) XB[(db * 16 + r) * 64] = o[db][r] * a1; }
                }
                asm volatile("s_waitcnt lgkmcnt(0)\n\ts_barrier" ::: "memory");
                if (comp == 0) {
                    if (hio == 0) wsf2[r32o] = linv;
                    LDS_WAIT();
                    float gsub[4];
#pragma unroll
                    for (int db = 0; db < 4; ++db) gsub[db] = args.in[8][db * 32 + r32o] * (1.0f - LAMBDA_INIT);
#pragma unroll
                    for (int r = 0; r < 16; ++r) {
                        const int qq = crow(r, hio); const float a0 = wsf2[qq];
                        float v[4], ss = 0.f;
#pragma unroll
                        for (int db = 0; db < 4; ++db) { v[db] = o[db][r] * a0 - XB[(db * 16 + r) * 64]; ss += v[db] * v[db]; }
                        ss += __shfl_xor(ss, 1); ss += __shfl_xor(ss, 2); ss += __shfl_xor(ss, 4); ss += __shfl_xor(ss, 8); ss += __shfl_xor(ss, 16);
                        const float rs = 1.0f / sqrtf(ss * (1.0f / 128.0f) + LN_EPS);
                        bf16* op = AC + (rowbase + 32 * p + qq) * DM + h * 128 + r32o;
#pragma unroll
                        for (int db = 0; db < 4; ++db) op[db * 32] = (bf16)(cvt_pk_bf16(v[db] * rs * gsub[db], 0.f) & 0xffffu);
                    }
                }
            }
            asm volatile("s_waitcnt lgkmcnt(0)\n\ts_barrier" ::: "memory");
        }
#endif
#ifndef NO_CONV
        {
            LAS float* WP = (LAS float*)(F.lds + RING_OFF);
            for (int idx = tid; idx < 47 * 512; idx += NWAVES * 64) { const int jj = idx >> 9, ch = idx & 511, j = jj - 7; WP[idx] = (j >= 0 && j <= 30) ? args.in[9][j * 512 + ch] : 0.f; }
            __syncthreads();
            const int ch0 = lane * 8;
            for (int rep9_ = 0; rep9_ < NREP(9); ++rep9_)
            for (int item = gw; item < NTOK / 8; item += NGW) {
                const int t0 = item * 8, tpos = t0 & (SEQ - 1);
                float acc[8][8];
                { const f32x4 b0 = *(const f32x4*)(args.in[10] + ch0), b1 = *(const f32x4*)(args.in[10] + ch0 + 4);
#pragma unroll
                  for (int tt = 0; tt < 8; ++tt) { acc[tt][0] = b0[0]; acc[tt][1] = b0[1]; acc[tt][2] = b0[2]; acc[tt][3] = b0[3]; acc[tt][4] = b1[0]; acc[tt][5] = b1[1]; acc[tt][6] = b1[2]; acc[tt][7] = b1[3]; } }
                u32x4 cur[4], nxt[4];
                const bf16* hg0 = HG + (size_t)t0 * AW + ch0;
#pragma unroll
                for (int ii = 0; ii < 4; ++ii) { const bool ok_ = (tpos - 30 + ii >= 0); const u32x4 v_ = *(const u32x4*)(hg0 + (ok_ ? (ii - 30) * AW : 0)); cur[ii] = ok_ ? v_ : (u32x4){0u, 0u, 0u, 0u}; }
#pragma unroll 1
                for (int ck = 0; ck < 10; ++ck) {
#pragma unroll
                    for (int ii = 0; ii < 4; ++ii) { const int i_ = (ck + 1) * 4 + ii; const bool ok_ = (i_ < 38) && (tpos - 30 + i_ >= 0); const u32x4 v_ = *(const u32x4*)(hg0 + (ok_ ? (i_ - 30) * AW : 0)); nxt[ii] = ok_ ? v_ : (u32x4){0u, 0u, 0u, 0u}; }
                    const LAS float* wck = WP + ck * 4 * 512 + ch0;
#pragma unroll
                    for (int ii = 0; ii < 4; ++ii) {
                        const u32x4 hw = cur[ii];
                        float hv[8]; hv[0] = bf_lo(hw.x); hv[1] = bf_hi(hw.x); hv[2] = bf_lo(hw.y); hv[3] = bf_hi(hw.y); hv[4] = bf_lo(hw.z); hv[5] = bf_hi(hw.z); hv[6] = bf_lo(hw.w); hv[7] = bf_hi(hw.w);
                        const LAS float* wr_ = wck + ii * 512;
#pragma unroll
                        for (int tt = 0; tt < 8; ++tt) { const f32x4 w0 = *(const LAS f32x4*)(wr_ + (7 - tt) * 512), w1 = *(const LAS f32x4*)(wr_ + (7 - tt) * 512 + 4);
                            acc[tt][0] += w0[0] * hv[0]; acc[tt][1] += w0[1] * hv[1]; acc[tt][2] += w0[2] * hv[2]; acc[tt][3] += w0[3] * hv[3];
                            acc[tt][4] += w1[0] * hv[4]; acc[tt][5] += w1[1] * hv[5]; acc[tt][6] += w1[2] * hv[6]; acc[tt][7] += w1[3] * hv[7]; }
                    }
#pragma unroll
                    for (int ii = 0; ii < 4; ++ii) cur[ii] = nxt[ii];
                }
                const f32x4 g0 = *(const f32x4*)(args.in[11] + ch0), g1 = *(const f32x4*)(args.in[11] + ch0 + 4), c0 = *(const f32x4*)(args.in[12] + ch0), c1 = *(const f32x4*)(args.in[12] + ch0 + 4);
#pragma unroll
                for (int tt = 0; tt < 8; ++tt) {
                    float s = 0.f;
#pragma unroll
                    for (int k = 0; k < 8; ++k) s += acc[tt][k];
                    const float mean = wave_sum(s) * (1.0f / 512.0f); float s2 = 0.f;
#pragma unroll
                    for (int k = 0; k < 8; ++k) { acc[tt][k] -= mean; s2 += acc[tt][k] * acc[tt][k]; }
                    const float rstd = 1.0f / sqrtf(wave_sum(s2) * (1.0f / 512.0f) + LN_EPS);
                    float y[8];
#pragma unroll
                    for (int k = 0; k < 8; ++k) { const float gg = k < 4 ? g0[k & 3] : g1[k & 3], cc = k < 4 ? c0[k & 3] : c1[k & 3]; const float v = acc[tt][k] * rstd * gg + cc; y[k] = v * sigmoidf_(v); }
                    u32x4 w; w.x = cvt_pk_bf16(y[0], y[1]); w.y = cvt_pk_bf16(y[2], y[3]); w.z = cvt_pk_bf16(y[4], y[5]); w.w = cvt_pk_bf16(y[6], y[7]);
                    *(u32x4*)(AC + (size_t)(t0 + tt) * DM + 512 + ch0) = w;
                }
            }
            __syncthreads();
        }
#endif
      }
        if (BOTH(2)) GRID_BAR();
    }

    if (IN(3)) {
        pg8::DenseOrder S; S.init(NTOK, DM, F.G, (int)blockIdx.x, Wout_t);
        pg8::EpiOut E{Y1, XN};
        pg8::gemm_phase<pg8::EpiOut, pg8::DenseOrder>(F.lds + RING_OFF, (const char*)AC, S, E);
        if (NREP(3) == 2) { pg8::gemm_phase<pg8::EpiOut, pg8::DenseOrder>(F.lds + RING_OFF, (const char*)AC, S, E); }
        if (BOTH(3)) GRID_BAR();
    }

    if (IN(4)) {
        constexpr int XSTR = 1028;
        LAS float* XS = (LAS float*)(F.lds + RING_OFF);
        LAS float* PL = (LAS float*)(F.lds + RING_OFF + 65792);
        LAS float* LG = (LAS float*)(F.lds + RING_OFF + 82176);
        LAS int* SEL = (LAS int*)(F.lds + RING_OFF + 84224);
        LAS float* GT = (LAS float*)(F.lds + RING_OFF + 85248);
        LAS int* RK = (LAS int*)(F.lds + RING_OFF + 86272);
        LAS int* LCNT = (LAS int*)(F.lds + RING_OFF + 87296);
        LAS int* GBASE = (LAS int*)(F.lds + RING_OFF + 87424);
        if (tid < 32) LCNT[tid] = 0;
        float rwf[32][2];
#pragma unroll
        for (int s = 0; s < 32; ++s) { const int k = 128 * wave + 4 * s + (lane >> 4); rwf[s][0] = args.in[16][k * 32 + (lane & 15)]; rwf[s][1] = args.in[16][k * 32 + 16 + (lane & 15)]; }
        __syncthreads();
        int gi = 0;
        for (int rep10_ = 0; rep10_ < NREP(10); ++rep10_) {
        if (rep10_ == 1) { __syncthreads(); if (tid < 32) LCNT[tid] = 0; __syncthreads(); }
        gi = 0;
        for (int g = blockIdx.x; g < NTOK / 16; g += F.G, ++gi) {
#pragma unroll
            for (int rr = 0; rr < 2; ++rr) {
                const int lr = 2 * wave + rr; const size_t row = (size_t)g * 16 + lr;
                const GAS f32x4* xr = (const GAS f32x4*)(Y1 + row * DM) + lane;
                f32x4 v[4]; float s = 0.f;
#pragma unroll
                for (int j = 0; j < 4; ++j) { v[j] = xr[64 * j]; s += (v[j].x + v[j].y) + (v[j].z + v[j].w); }
                const float mean = wave_sum(s) * (1.f / DM); float s2 = 0.f;
#pragma unroll
                for (int j = 0; j < 4; ++j) { v[j] = v[j] - mean; s2 += (v[j].x * v[j].x + v[j].y * v[j].y) + (v[j].z * v[j].z + v[j].w * v[j].w); }
                const float rstd = 1.f / sqrtf(wave_sum(s2) * (1.f / DM) + LN_EPS);
                GAS u32x2* o8 = (GAS u32x2*)(X1 + row * DM) + lane;
#pragma unroll
                for (int j = 0; j < 4; ++j) { const f32x4 gg = *((const GAS f32x4*)args.in[14] + lane + 64 * j), bb = *((const GAS f32x4*)args.in[15] + lane + 64 * j);
                    const f32x4 y = v[j] * rstd * gg + bb; u32x2 w; w.x = cvt_pk_bf16(y.x, y.y); w.y = cvt_pk_bf16(y.z, y.w); o8[64 * j] = w;
                    *((GAS unsigned*)(X1Q + row * DM) + lane + 64 * j) = pk4_fp8(y.x * SX8, y.y * SX8, y.z * SX8, y.w * SX8);
                    *(LAS f32x4*)(XS + lr * XSTR + 4 * lane + 256 * j) = y; }
            }
            __syncthreads();
            {
                f32x4 a0 = (f32x4){0.f, 0.f, 0.f, 0.f}, a1 = a0;
                const LAS float* xp = XS + (lane & 15) * XSTR + 128 * wave + (lane >> 4);
#pragma unroll
                for (int s = 0; s < 32; ++s) { const float a = xp[4 * s];
                    a0 = __builtin_amdgcn_mfma_f32_16x16x4f32(a, rwf[s][0], a0, 0, 0, 0);
                    a1 = __builtin_amdgcn_mfma_f32_16x16x4f32(a, rwf[s][1], a1, 0, 0, 0); }
#pragma unroll
                for (int r = 0; r < 4; ++r) { PL[(wave * 16 + 4 * (lane >> 4) + r) * 32 + (lane & 15)] = a0[r]; PL[(wave * 16 + 4 * (lane >> 4) + r) * 32 + 16 + (lane & 15)] = a1[r]; }
            }
            __syncthreads();
            {
                const int row = 2 * wave + (lane >> 5), e = lane & 31; float lg = args.in[17][e];
#pragma unroll
                for (int w = 0; w < 8; ++w) lg += PL[(w * 16 + row) * 32 + e];
                int se[4]; float sv[4];
#pragma unroll
                for (int k = 0; k < 4; ++k) { float bv = lg; int bi = e;
#pragma unroll
                    for (int off = 16; off >= 1; off >>= 1) { const float ov = __shfl_xor(bv, off); const int oi = __shfl_xor(bi, off); const bool take = (ov > bv) || (ov == bv && oi < bi); bv = take ? ov : bv; bi = take ? oi : bi; }
                    se[k] = bi; sv[k] = bv; if (e == bi) lg = -INFINITY; }
                float ex[4], es = 0.f;
#pragma unroll
                for (int k = 0; k < 4; ++k) { ex[k] = __expf(sv[k] - sv[0]); es += ex[k]; }
                const float inv = 1.0f / es; const int lrow = gi * 16 + row;
                if (e < 4) { const int ek = e == 0 ? se[0] : (e == 1 ? se[1] : (e == 2 ? se[2] : se[3])); const float gk = (e == 0 ? ex[0] : (e == 1 ? ex[1] : (e == 2 ? ex[2] : ex[3]))) * inv;
                    SEL[lrow * 4 + e] = ek; GT[lrow * 4 + e] = gk; RK[lrow * 4 + e] = atomicAdd((int*)&LCNT[ek], 1); }
            }
        }
        }
        __syncthreads();
        if (tid < 32) GBASE[tid] = (int)__hip_atomic_fetch_add(F.ctl + CW_GCNT + 64 * tid, (unsigned)LCNT[tid], RLX_AGENT);
        __syncthreads();
        if (tid < 256) {
            const int lrow = tid >> 2, k = tid & 3, gidx = lrow >> 4;
            if (gidx < gi) { const int g = blockIdx.x + gidx * F.G, token = g * 16 + (lrow & 15), p = token * 4 + k, e = SEL[lrow * 4 + k];
                LIST[e * LISTCAP + GBASE[e] + RK[lrow * 4 + k]] = p; GATEW[p] = GT[lrow * 4 + k]; }
        }
        __syncthreads();
        if (BOTH(4)) GRID_BAR();
    }

    if (IN(5) || IN(6)) {
        LAS int* TP = (LAS int*)(F.lds + MOE_TP_OFF); LAS int* CN = TP + 64;
        if (tid < 32) CN[tid] = (int)__hip_atomic_load(F.ctl + CW_GCNT + 64 * tid, RLX_AGENT);
        __syncthreads();
        if (tid == 0) { int a = 0; for (int e = 0; e < 32; ++e) { TP[e] = a; a += (CN[e] + 255) >> 8; } TP[32] = a; }
        __syncthreads();
    }
    if (IN(5)) {
        pg8::MoeOrder<8, true, 1024> S{(const LAS int*)(F.lds + MOE_TP_OFF), (const LAS int*)(F.lds + MOE_TP_OFF) + 64, F.G, F.vcu, lane, LIST, (const char*)Wgu_t, (size_t)2048 * DM};
        pg8::EpiSwiglu E{HID, args.in[19]};
        pg8::gemm_phase<pg8::EpiSwiglu, pg8::MoeOrder<8, true, 1024>, true>(F.lds + RING_OFF, (const char*)X1Q, S, E);
        if (NREP(5) == 2) { pg8::gemm_phase<pg8::EpiSwiglu, pg8::MoeOrder<8, true, 1024>, true>(F.lds + RING_OFF, (const char*)X1Q, S, E); }
        if (BOTH(5)) GRID_BAR();
    }
    if (IN(6)) {
        pg8::MoeOrder<4, false, 1024> S{(const LAS int*)(F.lds + MOE_TP_OFF), (const LAS int*)(F.lds + MOE_TP_OFF) + 64, F.G, F.vcu, lane, LIST, (const char*)Wd_t, (size_t)DM * DFF};
        pg8::EpiDown E{YP, args.in[21], LIST, GATEW};
        pg8::gemm_phase<pg8::EpiDown, pg8::MoeOrder<4, false, 1024>, true>(F.lds + RING_OFF, (const char*)HID, S, E);
        if (NREP(6) == 2) { pg8::gemm_phase<pg8::EpiDown, pg8::MoeOrder<4, false, 1024>, true>(F.lds + RING_OFF, (const char*)HID, S, E); }
        if (BOTH(6)) GRID_BAR();
    }
    if (IN(7)) {
        const unsigned bad = (MK_N_LAUNCHES == 1) ? __hip_atomic_load((gu32*)(F.ctl + CW_BAR + XB_TMO), RLX_AGENT) : 0u;
        for (int rep_ = 0; rep_ < NREP(7); ++rep_)
        for (int row = gw; row < NTOK; row += NGW) {
            float v[16];
#pragma unroll
            for (int j = 0; j < 2; ++j) { const u32x4 xw = *(const u32x4*)(X1 + (size_t)row * DM + 8 * lane + 512 * j);
                v[8 * j + 0] = ALPHA * bf_lo(xw.x); v[8 * j + 1] = ALPHA * bf_hi(xw.x); v[8 * j + 2] = ALPHA * bf_lo(xw.y); v[8 * j + 3] = ALPHA * bf_hi(xw.y);
                v[8 * j + 4] = ALPHA * bf_lo(xw.z); v[8 * j + 5] = ALPHA * bf_hi(xw.z); v[8 * j + 6] = ALPHA * bf_lo(xw.w); v[8 * j + 7] = ALPHA * bf_hi(xw.w); }
#pragma unroll
            for (int k = 0; k < 4; ++k)
#pragma unroll
                for (int j = 0; j < 2; ++j) { const u32x4 yw = *(const u32x4*)(YP + ((size_t)row * 4 + k) * DM + 8 * lane + 512 * j);
                    v[8 * j + 0] += bf_lo(yw.x); v[8 * j + 1] += bf_hi(yw.x); v[8 * j + 2] += bf_lo(yw.y); v[8 * j + 3] += bf_hi(yw.y);
                    v[8 * j + 4] += bf_lo(yw.z); v[8 * j + 5] += bf_hi(yw.z); v[8 * j + 6] += bf_lo(yw.w); v[8 * j + 7] += bf_hi(yw.w); }
            float s = 0.f;
#pragma unroll
            for (int i = 0; i < 16; ++i) s += v[i];
            const float mean = wave_sum(s) * (1.f / DM); float s2 = 0.f;
#pragma unroll
            for (int i = 0; i < 16; ++i) { v[i] -= mean; s2 += v[i] * v[i]; }
            const float rstd = 1.f / sqrtf(wave_sum(s2) * (1.f / DM) + LN_EPS);
#pragma unroll
            for (int j = 0; j < 2; ++j)
#pragma unroll
                for (int hh = 0; hh < 2; ++hh) { const int c0 = 8 * lane + 512 * j + 4 * hh;
                    const f32x4 gg = *(const f32x4*)(args.in[22] + c0), bb = *(const f32x4*)(args.in[23] + c0);
                    f32x4 o; o[0] = v[8 * j + 4 * hh + 0] * rstd * gg[0] + bb[0]; o[1] = v[8 * j + 4 * hh + 1] * rstd * gg[1] + bb[1]; o[2] = v[8 * j + 4 * hh + 2] * rstd * gg[2] + bb[2]; o[3] = v[8 * j + 4 * hh + 3] * rstd * gg[3] + bb[3];
                    if (bad) { const float qn = __builtin_nanf(""); o = (f32x4){qn, qn, qn, qn}; }
                    *(f32x4*)(args.out + (size_t)row * DM + c0) = o; }
        }
    }
#undef IN
#undef BOTH
#undef GRID_BAR
}

extern "C" void kernel_launch(void* const* d_in, const int* in_sizes, int n_in, void* d_out, int out_size, void* d_ws, size_t ws_size, hipStream_t stream) {
    static int grid = 0;
    if (grid == 0) {
        if (n_in != 24 || in_sizes[0] != NTOK * DM || out_size != NTOK * DM || ws_size < WS_END) { fprintf(stderr, "kernel_launch: unexpected shapes (n_in %d, in0 %d, out %d, ws %zu); nothing launched\n", n_in, n_in > 0 ? in_sizes[0] : -1, out_size, ws_size); grid = -1; return; }
        int dev = 0, cus = 0, per_cu = 0;
        if (hipGetDevice(&dev) != hipSuccess || hipDeviceGetAttribute(&cus, hipDeviceAttributeMultiprocessorCount, dev) != hipSuccess) { grid = -1; return; }
        if (hipFuncSetAttribute((const void*)hymba_fwd, hipFuncAttributeMaxDynamicSharedMemorySize, LDS_BYTES) != hipSuccess) { fprintf(stderr, "kernel_launch: hipFuncSetAttribute failed\n"); grid = -1; return; }
        if (hipOccupancyMaxActiveBlocksPerMultiprocessor(&per_cu, (const void*)hymba_fwd, NWAVES * 64, LDS_BYTES) != hipSuccess || per_cu < 1)
            fprintf(stderr, "kernel_launch: note: occupancy query reports %d workgroups per CU\n", per_cu);
        (void)hipGetLastError();
        grid = cus;
        if (grid != 256) fprintf(stderr, "kernel_launch: %d CUs; this kernel is laid out for 256\n", grid);
    }
    if (grid < 0) return;
    (void)hipMemsetAsync((char*)d_ws + WS_CTL, 0, CTL_ZERO_BYTES, stream);
    Args a{};
    for (int i = 0; i < 24; ++i) a.in[i] = (const float*)d_in[i];
    a.out = (float*)d_out; a.ws = (unsigned char*)d_ws;
    if (MK_N_LAUNCHES == 1) { a.ph_lo = 0; a.ph_hi = 8; hipLaunchKernelGGL(hymba_fwd, dim3(grid), dim3(NWAVES * 64), LDS_BYTES, stream, a); }
    else for (int li = 0; li < 8; ++li) { a.ph_lo = li; a.ph_hi = li + 1; hipLaunchKernelGGL(hymba_fwd, dim3(grid), dim3(NWAVES * 64), LDS_BYTES, stream, a); }
}
```

```cpp
#include <hip/hip_runtime.h>
#include <cstdio>
#include <cstdint>

#ifndef MK_N_LAUNCHES
#define MK_N_LAUNCHES 1
#endif

#define GAS __attribute__((address_space(1)))
#define LAS __attribute__((address_space(3)))
typedef unsigned short bf16;
typedef short bf16x8 __attribute__((ext_vector_type(8)));
typedef short s16x4 __attribute__((ext_vector_type(4)));
typedef float f32x2 __attribute__((ext_vector_type(2)));
typedef float f32x4 __attribute__((ext_vector_type(4)));
typedef float f32x16 __attribute__((ext_vector_type(16)));
typedef unsigned u32x2 __attribute__((ext_vector_type(2)));
typedef unsigned u32x4 __attribute__((ext_vector_type(4)));
typedef GAS unsigned gu32;
#define RLX_AGENT __ATOMIC_RELAXED, __HIP_MEMORY_SCOPE_AGENT
#define LDS_WAIT() asm volatile("s_waitcnt lgkmcnt(0)" ::: "memory")
#define VM_WAIT() asm volatile("s_waitcnt vmcnt(0)" ::: "memory")

constexpr int NTOK = 16384, DM = 1024, SEQ = 2048;
constexpr int IN_COLS = 2560, AW = 512;
constexpr int NEXP = 32, TOPK = 4, DFF = 1024, NPAIR = NTOK * TOPK;
constexpr int LISTCAP = NTOK;
constexpr int HIDROWS = NPAIR + NEXP * 256;
constexpr float LN_EPS = 1e-5f;
constexpr float ALPHA = 1.189207115002721f;
constexpr float LOG2E = 1.4426950408889634f;
constexpr float QSCALE = 0.125f * LOG2E;
constexpr float LAMBDA_INIT = 0.2f;
constexpr int NWAVES = 8;
constexpr float SX8 = 4.0f, SW8 = 64.0f, SH8 = 4.0f;

constexpr size_t MiB = 1u << 20;
constexpr size_t WS_CTL = 0, CTL_ZERO_BYTES = 1 * MiB;
constexpr size_t WS_WIN = 2 * MiB;
constexpr size_t WS_WOUT = 8 * MiB;
constexpr size_t WS_WGU = 16 * MiB;
constexpr size_t WS_WD = 144 * MiB;
constexpr size_t WS_XN = 208 * MiB;
constexpr size_t WS_Q = 240 * MiB, WS_K = 256 * MiB, WS_V = 272 * MiB, WS_HG = 288 * MiB;
constexpr size_t WS_AC = 304 * MiB;
constexpr size_t WS_Y1 = 336 * MiB;
constexpr size_t WS_X1 = 400 * MiB;
constexpr size_t WS_HID = 432 * MiB;
constexpr size_t WS_YP = 576 * MiB;
constexpr size_t WS_LIST = 704 * MiB;
constexpr size_t WS_GATE = 706 * MiB;
constexpr size_t WS_X1Q = 708 * MiB;
constexpr size_t WS_END = 724 * MiB;
constexpr int CW_TMO = 0;
constexpr int CW_BAR = 4096;
constexpr int CW_GCNT = 8192;

constexpr int RING_OFF = 0, RING_BYTES = 131072;
constexpr int LDSCTL_OFF = RING_BYTES, MISC_OFF = LDSCTL_OFF + 320;
constexpr int MOE_TP_OFF = LDSCTL_OFF + 1024;
constexpr int LDS_BYTES = 147456;

__device__ __forceinline__ unsigned cvt_pk_bf16(float lo, float hi) { unsigned r; asm volatile("v_cvt_pk_bf16_f32 %0, %1, %2" : "=v"(r) : "v"(lo), "v"(hi)); return r; }
__device__ __forceinline__ unsigned pk4_fp8(float a, float b, float c, float d) { int w = 0; w = __builtin_amdgcn_cvt_pk_fp8_f32(a, b, w, false); w = __builtin_amdgcn_cvt_pk_fp8_f32(c, d, w, true); return (unsigned)w; }
__device__ __forceinline__ float bf_lo(unsigned w) { return __uint_as_float(w << 16); }
__device__ __forceinline__ float bf_hi(unsigned w) { return __uint_as_float(w & 0xffff0000u); }
__device__ __forceinline__ float fast_exp2(float x) { return __builtin_amdgcn_exp2f(x); }
__device__ __forceinline__ float fast_rcp(float x) { return __builtin_amdgcn_rcpf(x); }
__device__ __forceinline__ float sigmoidf_(float x) { return fast_rcp(1.0f + fast_exp2(-LOG2E * x)); }
__device__ __forceinline__ float wave_sum(float v) {
#pragma unroll
    for (int o = 1; o < 64; o <<= 1) v += __shfl_xor(v, o);
    return v;
}

namespace pg8 {
constexpr int BM = 256, BK = 64, HALF = 128, HTB = HALF * BK * 2, STAGE_BYTES = 8 * HTB, NXCD = 8, WGM = 8, KD = 1024;
__host__ __device__ __forceinline__ int lds_byte(int r, int c) { const int st = (r >> 4) * 2 + (c >> 5), rr = r & 15, cc = c & 31, ob = rr * 64 + cc * 2; return st * 1024 + (ob ^ (((ob >> 9) & 1) << 5)); }
__host__ __device__ __forceinline__ void stage_rc(int b, int& R, int& C) { const int st = b / 1024, sb = b % 1024, swz = sb ^ (((sb >> 9) & 1) << 5); R = (st >> 1) * 16 + swz / 64; C = (st & 1) * 32 + (swz % 64) / 2; }
__host__ __device__ __forceinline__ int perm32(int rho) { const int n = rho >> 4, i = rho & 15; return 8 * (i >> 2) + 4 * n + (i & 3); }

struct Unit { int pm, pn, e, mtl, cnt; };

struct DenseOrder {
    int nM, nN, nwg, G, c; const char* Bt;
    __device__ __forceinline__ void init(int M, int N, int G_, int c_, const void* Bt_) { nM = M / BM; nN = N / BM; nwg = nM * nN; G = G_; c = c_; Bt = (const char*)Bt_; }
    __device__ __forceinline__ bool next(int i, Unit& u) const {
        const long L = (long)i * G + c; if (L >= nwg) return false;
        int wgid = (int)L; { const int q = nwg / NXCD, r = nwg % NXCD, xcd = wgid % NXCD, off = wgid / NXCD; wgid = (xcd < r ? xcd * (q + 1) : r * (q + 1) + (xcd - r) * q) + off; }
        const int nig = WGM * nN, gid = wgid / nig, fm = gid * WGM, gsz = (nM - fm) < WGM ? (nM - fm) : WGM;
        u.pm = fm + ((wgid % nig) % gsz); u.pn = (wgid % nig) / gsz; u.e = 0; u.mtl = 0; u.cnt = 0; return true;
    }
    __device__ __forceinline__ unsigned arow_off(const Unit& u, int rl) const { return (unsigned)(u.pm * BM + rl) * (unsigned)(KD * 2); }
    __device__ __forceinline__ const char* bbase(const Unit& u) const { return Bt + (size_t)u.pn * (size_t)(BM * KD * 2); }
};
template <int NPN, bool GATHER, int ROWB> struct MoeOrder {
    const LAS int* tp; const LAS int* cn; int G, vcu, lane; const int* list; const char* Bt; size_t bstride;
    __device__ __forceinline__ bool next(int i, Unit& u) const {
        const int L = i * G + vcu, chunk = L >> 5, s = L & 31;
        const int mt = (NPN == 8) ? chunk * 4 + (s & 3) : chunk * 8 + (s & 7), pn = (NPN == 8) ? (s >> 2) : (s >> 3);
        const int MT = tp[32];
        if (mt >= MT) return false;
        const int lj = lane < 1 ? 1 : (lane > 32 ? 32 : lane);
        const unsigned long long bm = __ballot(lane >= 1 && lane <= 32 && tp[lj] <= mt);
        const int e = __builtin_amdgcn_readfirstlane(__popcll(bm));
        u.pm = mt; u.pn = pn; u.e = e; u.mtl = __builtin_amdgcn_readfirstlane(mt - tp[e]); u.cnt = __builtin_amdgcn_readfirstlane(cn[e]); return true;
    }
    __device__ __forceinline__ unsigned arow_off(const Unit& u, int rl) const {
        if (GATHER) { int pos = u.mtl * BM + rl; pos = pos < u.cnt ? pos : u.cnt - 1; const int p = list[u.e * LISTCAP + pos]; return (unsigned)(p >> 2) * (unsigned)ROWB; }
        else return (unsigned)(u.pm * BM + rl) * (unsigned)ROWB;
    }
    __device__ __forceinline__ const char* bbase(const Unit& u) const { return Bt + (size_t)u.e * bstride + (size_t)u.pn * (size_t)(BM * ROWB); }
};

typedef int i32x4 __attribute__((ext_vector_type(4)));
typedef int i32x8 __attribute__((ext_vector_type(8)));
template <class Epi, class Sched, bool FP8 = false>
__device__ __forceinline__ void gemm_phase(LAS unsigned char* lds, const char* Abase, const Sched& S, const Epi& E) {
    const int tid = threadIdx.x, wid = __builtin_amdgcn_readfirstlane(tid >> 6), lane = tid & 63, wr = wid >> 2, wc = wid & 3, fr = lane & 15, fq = lane >> 4;
    constexpr int ROWB = FP8 ? KD : KD * 2, nt = ROWB / (BK * 2);
    int RA[2]; unsigned CA2[2], voffB[2];
#pragma unroll
    for (int i = 0; i < 2; ++i) { int R, C; stage_rc(tid * 16 + i * 8192, R, C); const int Rb = Epi::PERM ? ((R & ~31) + perm32(R & 31)) : R;
        RA[i] = R; CA2[i] = (unsigned)C * 2u; voffB[i] = (unsigned)(Rb * ROWB + C * 2); }
    constexpr size_t kstep = (size_t)(BK * 2);
    constexpr size_t hstep = (size_t)HALF * ROWB;
    const unsigned ldsw = (unsigned)wid * 1024u;
    const int aoff = lds_byte(wr * 64 + fr, fq * 8), boff = lds_byte(wc * 32 + fr, fq * 8);
#define PG8_SA(b, h) (((b) * 2 + (h)) * HTB)
#define PG8_SB(b, h) ((4 + (b) * 2 + (h)) * HTB)
#define PG8_STAGE_B(bufoff, gbase) do { _Pragma("unroll") for (int _i = 0; _i < 2; ++_i) \
        __builtin_amdgcn_global_load_lds((const unsigned*)((const char*)(gbase) + voffB[_i]), (LAS unsigned*)(lds + (bufoff) + ldsw + _i * 8192), 16, 0, 0); } while (0)
#define PG8_STAGE_A(bufoff, offs, kb) do { _Pragma("unroll") for (int _i = 0; _i < 2; ++_i) \
        __builtin_amdgcn_global_load_lds((const unsigned*)(Abase + (size_t)(offs)[_i] + (size_t)(kb)), (LAS unsigned*)(lds + (bufoff) + ldsw + _i * 8192), 16, 0, 0); } while (0)
#define PG8_LD8(p) __builtin_shufflevector(*(const LAS i32x4*)(p), *(const LAS i32x4*)((p) + 1024), 0, 1, 2, 3, 4, 5, 6, 7)
#define PG8_LDA(dst, b, h) do { _Pragma("unroll") for (int m = 0; m < 4; ++m) { if constexpr (FP8) dst##8[m] = PG8_LD8(lds + PG8_SA(b, h) + aoff + m * 2048); else { _Pragma("unroll") for (int k = 0; k < 2; ++k) dst[m][k] = *(const LAS bf16x8*)(lds + PG8_SA(b, h) + aoff + m * 2048 + k * 1024); } } } while (0)
#define PG8_LDB(dst, b, h) do { _Pragma("unroll") for (int n = 0; n < 2; ++n) { if constexpr (FP8) dst##8[n] = PG8_LD8(lds + PG8_SB(b, h) + boff + n * 2048); else { _Pragma("unroll") for (int k = 0; k < 2; ++k) dst[n][k] = *(const LAS bf16x8*)(lds + PG8_SB(b, h) + boff + n * 2048 + k * 1024); } } } while (0)
#define PG8_MMA(ai, bj, At, Bt) do { __builtin_amdgcn_s_setprio(1); _Pragma("unroll") for (int m = 0; m < 4; ++m) _Pragma("unroll") for (int n = 0; n < 2; ++n) { \
        if constexpr (FP8) asm volatile("s_nop 1\n\tv_mfma_f32_16x16x128_f8f6f4 %0, %1, %2, %0" : "+v"(acc[ai][bj][m][n]) : "v"(Bt##8[n]), "v"(At##8[m])); \
        else { _Pragma("unroll") for (int k = 0; k < 2; ++k) acc[ai][bj][m][n] = __builtin_amdgcn_mfma_f32_16x16x32_bf16(Bt[n][k], At[m][k], acc[ai][bj][m][n], 0, 0, 0); } } \
        __builtin_amdgcn_s_setprio(0); } while (0)
#define PG8_WAIT_V(n) asm volatile("s_waitcnt vmcnt(" #n ")" ::: "memory")
#define PG8_WAIT_L(n) asm volatile("s_waitcnt lgkmcnt(" #n ")" ::: "memory")
#define PG8_BAR __builtin_amdgcn_s_barrier()
#define PG8_SCHED __builtin_amdgcn_sched_barrier(0)
    Unit cur, nxt; int ui = 0;
    if (!S.next(0, cur)) return;
    f32x4 acc[2][2][4][2];
#pragma unroll
    for (int a = 0; a < 2; ++a)
#pragma unroll
        for (int b = 0; b < 2; ++b)
#pragma unroll
            for (int m = 0; m < 4; ++m)
#pragma unroll
                for (int n = 0; n < 2; ++n) { acc[a][b][m][n] = (f32x4){0.f, 0.f, 0.f, 0.f}; asm volatile("" : "+v"(acc[a][b][m][n])); }
    bf16x8 At[4][2], B0[2][2], B1[2][2];
    i32x8 At8[4], B08[2], B18[2];
    unsigned ao[2][2], no[2][2];
#pragma unroll
    for (int h = 0; h < 2; ++h)
#pragma unroll
        for (int i = 0; i < 2; ++i) ao[h][i] = S.arow_off(cur, h * HALF + RA[i]) + CA2[i];
    const char* cB = S.bbase(cur);
    PG8_STAGE_B(PG8_SB(0, 0), cB); PG8_STAGE_B(PG8_SB(0, 1), cB + hstep); PG8_STAGE_A(PG8_SA(0, 0), ao[0], 0); PG8_STAGE_A(PG8_SA(0, 1), ao[1], 0);
    if (wr == 1) PG8_BAR;
    PG8_WAIT_V(2); PG8_BAR;
    PG8_STAGE_B(PG8_SB(1, 0), cB + kstep); PG8_STAGE_A(PG8_SA(1, 0), ao[0], kstep); PG8_STAGE_B(PG8_SB(1, 1), cB + hstep + kstep);
    PG8_WAIT_V(6); PG8_BAR;
    for (;;) {
        const bool has_next = S.next(ui + 1, nxt);
        const char* nB = cB;
        if (has_next) {
#pragma unroll
            for (int h = 0; h < 2; ++h)
#pragma unroll
                for (int i = 0; i < 2; ++i) no[h][i] = S.arow_off(nxt, h * HALF + RA[i]) + CA2[i];
            nB = S.bbase(nxt);
        } else {
#pragma unroll
            for (int h = 0; h < 2; ++h)
#pragma unroll
                for (int i = 0; i < 2; ++i) no[h][i] = ao[h][i];
        }
#pragma nounroll
        for (int t = 0; t < nt; t += 2) {
            const bool last = (t == nt - 2);
            const size_t kb1 = (size_t)(t + 1) * kstep;
            unsigned s2[2][2];
#pragma unroll
            for (int h = 0; h < 2; ++h)
#pragma unroll
                for (int i = 0; i < 2; ++i) s2[h][i] = last ? no[h][i] : ao[h][i];
            const size_t kb2 = last ? 0 : (size_t)(t + 2) * kstep, kb3 = kb2 + kstep;
            const char* b2 = last ? nB : cB + (size_t)(t + 2) * kstep; const char* b3 = b2 + kstep;
            PG8_LDB(B0, 0, 0); PG8_LDB(B1, 0, 1); PG8_SCHED; PG8_LDA(At, 0, 0); PG8_STAGE_A(PG8_SA(1, 1), ao[1], kb1);
            PG8_WAIT_V(8); PG8_WAIT_L(0); PG8_BAR; PG8_MMA(0, 0, At, B0); PG8_MMA(0, 1, At, B1); PG8_BAR; PG8_SCHED;
            PG8_LDA(At, 0, 1); PG8_STAGE_B(PG8_SB(0, 0), b2); PG8_STAGE_B(PG8_SB(0, 1), b2 + hstep); PG8_STAGE_A(PG8_SA(0, 0), s2[0], kb2);
            PG8_WAIT_V(8); PG8_WAIT_L(0); PG8_BAR; PG8_MMA(1, 0, At, B0); PG8_MMA(1, 1, At, B1); PG8_BAR; PG8_SCHED;
            PG8_LDB(B0, 1, 0); PG8_LDB(B1, 1, 1); PG8_SCHED; PG8_LDA(At, 1, 0); PG8_STAGE_A(PG8_SA(0, 1), s2[1], kb2);
            PG8_WAIT_V(8); PG8_WAIT_L(0); PG8_BAR; PG8_MMA(0, 0, At, B0); PG8_MMA(0, 1, At, B1); PG8_BAR; PG8_SCHED;
            PG8_LDA(At, 1, 1); PG8_STAGE_B(PG8_SB(1, 0), b3); PG8_STAGE_B(PG8_SB(1, 1), b3 + hstep); PG8_STAGE_A(PG8_SA(1, 0), s2[0], kb3);
            PG8_WAIT_V(8); PG8_WAIT_L(0); PG8_BAR; PG8_MMA(1, 0, At, B0); PG8_MMA(1, 1, At, B1); PG8_BAR; PG8_SCHED;
        }
        if (wr == 0) PG8_BAR;
        if constexpr (FP8) asm volatile("s_nop 15\n\ts_nop 7" ::: "memory");
        E(acc, cur, wr, wc, fr, fq);
        if (!has_next) break;
#pragma unroll
        for (int a = 0; a < 2; ++a)
#pragma unroll
            for (int b = 0; b < 2; ++b)
#pragma unroll
                for (int m = 0; m < 4; ++m)
#pragma unroll
                    for (int n = 0; n < 2; ++n) { acc[a][b][m][n] = (f32x4){0.f, 0.f, 0.f, 0.f}; asm volatile("" : "+v"(acc[a][b][m][n])); }
        cur = nxt; cB = nB; ++ui;
#pragma unroll
        for (int h = 0; h < 2; ++h)
#pragma unroll
            for (int i = 0; i < 2; ++i) ao[h][i] = no[h][i];
        if (wr == 1) PG8_BAR;
    }
    PG8_WAIT_V(0);
    PG8_BAR;
#undef PG8_SA
#undef PG8_SB
#undef PG8_STAGE_A
#undef PG8_STAGE_B
#undef PG8_LDA
#undef PG8_LDB
#undef PG8_MMA
#undef PG8_LD8
#undef PG8_WAIT_V
#undef PG8_WAIT_L
#undef PG8_BAR
#undef PG8_SCHED
}

struct EpiIn {
    static constexpr bool PERM = true;
    bf16* Q; size_t qkv_stride;
    __device__ __forceinline__ void operator()(const f32x4 (&acc)[2][2][4][2], const Unit& u, int wr, int wc, int fr, int fq) const {
        const int row0 = u.pm * BM + wr * 64 + fr; bf16* HG = Q + 3 * qkv_stride;
        if (u.pn < 6) {
            bf16* base = Q + (size_t)(u.pn >> 1) * qkv_stride; const float sc = u.pn < 2 ? QSCALE : 1.0f;
            const int col0 = (u.pn & 1) * 256 + wc * 32 + 8 * fq;
#pragma unroll
            for (int ai = 0; ai < 2; ++ai)
#pragma unroll
                for (int m = 0; m < 4; ++m) { bf16* rowp = base + (size_t)(row0 + ai * HALF + m * 16) * AW + col0;
#pragma unroll
                    for (int bj = 0; bj < 2; ++bj) { const f32x4 v0 = acc[ai][bj][m][0] * sc, v1 = acc[ai][bj][m][1] * sc;
                        u32x4 w; w.x = cvt_pk_bf16(v0[0], v0[1]); w.y = cvt_pk_bf16(v0[2], v0[3]); w.z = cvt_pk_bf16(v1[0], v1[1]); w.w = cvt_pk_bf16(v1[2], v1[3]);
                        *(u32x4*)(rowp + bj * HALF) = w; } }
        } else {
            const int col0 = (u.pn - 6) * 128 + wc * 32 + 8 * fq;
#pragma unroll
            for (int ai = 0; ai < 2; ++ai)
#pragma unroll
                for (int m = 0; m < 4; ++m) { bf16* rowp = HG + (size_t)(row0 + ai * HALF + m * 16) * AW + col0;
                    float o[8];
#pragma unroll
                    for (int n = 0; n < 2; ++n)
#pragma unroll
                        for (int j = 0; j < 4; ++j) o[n * 4 + j] = acc[ai][0][m][n][j] * sigmoidf_(acc[ai][1][m][n][j]);
                    u32x4 w; w.x = cvt_pk_bf16(o[0], o[1]); w.y = cvt_pk_bf16(o[2], o[3]); w.z = cvt_pk_bf16(o[4], o[5]); w.w = cvt_pk_bf16(o[6], o[7]);
                    *(u32x4*)rowp = w; }
        }
    }
};
struct EpiOut {
    static constexpr bool PERM = false;
    float* Y1; const bf16* XN;
    __device__ __forceinline__ void operator()(const f32x4 (&acc)[2][2][4][2], const Unit& u, int wr, int wc, int fr, int fq) const {
        const int row0 = u.pm * BM + wr * 64 + fr, col0 = u.pn * BM + wc * 32 + 4 * fq;
#pragma unroll
        for (int ai = 0; ai < 2; ++ai)
#pragma unroll
            for (int m = 0; m < 4; ++m) { const size_t ro = (size_t)(row0 + ai * HALF + m * 16) * DM + col0;
#pragma unroll
                for (int bj = 0; bj < 2; ++bj)
#pragma unroll
                    for (int n = 0; n < 2; ++n) { const u32x2 xw = *(const u32x2*)(XN + ro + bj * HALF + n * 16);
                        f32x4 o = acc[ai][bj][m][n]; o[0] += ALPHA * bf_lo(xw.x); o[1] += ALPHA * bf_hi(xw.x); o[2] += ALPHA * bf_lo(xw.y); o[3] += ALPHA * bf_hi(xw.y);
                        *(f32x4*)(Y1 + ro + bj * HALF + n * 16) = o; } }
    }
};
struct EpiSwiglu {
    static constexpr bool PERM = true;
    unsigned char* HID; const float* bgu;
    __device__ __forceinline__ void operator()(const f32x4 (&acc)[2][2][4][2], const Unit& u, int wr, int wc, int fr, int fq) const {
        const int row0 = u.pm * BM + wr * 64 + fr, ch0 = u.pn * 128 + wc * 32 + 8 * fq; constexpr float ISC = 1.0f / (SX8 * SW8);
        const float* bg = bgu + (size_t)u.e * 2048 + ch0; const float* bu = bg + 1024;
        f32x4 bgv[2], buv[2];
#pragma unroll
        for (int n = 0; n < 2; ++n) { bgv[n] = *(const f32x4*)(bg + 4 * n); buv[n] = *(const f32x4*)(bu + 4 * n); }
#pragma unroll
        for (int ai = 0; ai < 2; ++ai)
#pragma unroll
            for (int m = 0; m < 4; ++m) { unsigned char* rowp = HID + (size_t)(row0 + ai * HALF + m * 16) * DFF + ch0;
                float o[8];
#pragma unroll
                for (int n = 0; n < 2; ++n)
#pragma unroll
                    for (int j = 0; j < 4; ++j) { float g = acc[ai][0][m][n][j] * ISC + bgv[n][j], up = acc[ai][1][m][n][j] * ISC + buv[n][j];
                        g = fminf(g, 7.0f); up = fminf(fmaxf(up, -7.0f), 7.0f);
                        o[n * 4 + j] = g * sigmoidf_(1.702f * g) * (up + 1.0f) * SH8; }
                u32x2 w; w.x = pk4_fp8(o[0], o[1], o[2], o[3]); w.y = pk4_fp8(o[4], o[5], o[6], o[7]);
                *(u32x2*)rowp = w; }
    }
};
struct EpiDown {
    static constexpr bool PERM = true;
    bf16* YP; const float* bd; const int* list; const float* gatew;
    __device__ __forceinline__ void operator()(const f32x4 (&acc)[2][2][4][2], const Unit& u, int wr, int wc, int fr, int fq) const {
        const int rl0 = wr * 64 + fr, col0 = u.pn * BM + wc * 32 + 8 * fq;
        f32x4 bv[2][2];
#pragma unroll
        for (int bj = 0; bj < 2; ++bj)
#pragma unroll
            for (int n = 0; n < 2; ++n) bv[bj][n] = *(const f32x4*)(bd + (size_t)u.e * DM + col0 + bj * HALF + 4 * n);
#pragma unroll
        for (int ai = 0; ai < 2; ++ai)
#pragma unroll
            for (int m = 0; m < 4; ++m) { const int pos = u.mtl * BM + rl0 + ai * HALF + m * 16;
                if (pos < u.cnt) { const int p = list[u.e * LISTCAP + pos]; const float gw = gatew[p]; bf16* rowp = YP + (size_t)p * DM + col0;
#pragma unroll
                    for (int bj = 0; bj < 2; ++bj) { constexpr float ISC = 1.0f / (SH8 * SW8); const f32x4 v0 = (acc[ai][bj][m][0] * ISC + bv[bj][0]) * gw, v1 = (acc[ai][bj][m][1] * ISC + bv[bj][1]) * gw;
                        u32x4 w; w.x = cvt_pk_bf16(v0[0], v0[1]); w.y = cvt_pk_bf16(v0[2], v0[3]); w.z = cvt_pk_bf16(v1[0], v1[1]); w.w = cvt_pk_bf16(v1[2], v1[3]);
                        *(u32x4*)(rowp + bj * HALF) = w; } } }
    }
};
}

#define XB_TMO      128
#define XB_XCNT(j)  (256  + 64 * (j))
#define XB_XSUB(j)  (1280 + 64 * (j))
#define XB_XGEN(j)  (2304 + 64 * (j))
#define XB_TOP      3328
#define XB_TOPGEN   3392
#define XCD_BAR_WORDS 3456
#define XB_SPIN_CAP (1u << 18)
__device__ __forceinline__ unsigned xb_ld(unsigned* p)              { return __hip_atomic_load(p, __ATOMIC_RELAXED, __HIP_MEMORY_SCOPE_AGENT); }
__device__ __forceinline__ unsigned xb_add(unsigned* p, unsigned v) { return __hip_atomic_fetch_add(p, v, __ATOMIC_RELAXED, __HIP_MEMORY_SCOPE_AGENT); }
__device__ __forceinline__ unsigned xb_xcc_id() { return (unsigned)__builtin_amdgcn_s_getreg((3 << 11) | 20) & 0xFu; }
#define XB_SPIN(cond, bar) do { unsigned _sp = 0; while (cond) { __builtin_amdgcn_s_sleep(1); \
    if ((++_sp & 255u) == 0u) { if (xb_ld(&(bar)[XB_TMO])) break; if (_sp > XB_SPIN_CAP) { atomicAdd(&(bar)[XB_TMO], 1u); break; } } } } while (0)
struct XcdBarrier { unsigned* bar; unsigned x; volatile LAS unsigned* st; };
__device__ __forceinline__ XcdBarrier xcd_barrier_post(unsigned* bar, volatile LAS unsigned* st) {
    XcdBarrier b; b.bar = bar; b.x = xb_xcc_id(); b.st = st;
    if (threadIdx.x == 0) (void)xb_add(&bar[XB_XCNT(b.x)], 1u);
    return b;
}
__device__ __forceinline__ void xcd_barrier_complete(unsigned* bar, unsigned x, unsigned& nloc, unsigned& nx) {
    const unsigned G = gridDim.x * gridDim.y * gridDim.z;
    unsigned sum, cnt, mine, sp = 0u;
    for (;;) {
        sum = 0u; cnt = 0u; mine = 0u;
#pragma unroll
        for (unsigned j = 0; j < 16; ++j) { const unsigned c = xb_ld(&bar[XB_XCNT(j)]); sum += c; cnt += (c > 0u) ? 1u : 0u; mine = (j == x) ? c : mine; }
        if (sum == G) break;
        __builtin_amdgcn_s_sleep(1);
        if ((++sp & 255u) == 0u) { if (xb_ld(&bar[XB_TMO])) break; if (sp > XB_SPIN_CAP) { atomicAdd(&bar[XB_TMO], 1u); break; } }
    }
    nloc = mine > 0u ? mine : 1u; nx = cnt > 0u ? cnt : 1u;
}
__device__ __forceinline__ void xcd_barrier(const XcdBarrier& b) {
    asm volatile("s_waitcnt vmcnt(0)" ::: "memory");
    __syncthreads();
    if (threadIdx.x == 0) {
        unsigned* bar = b.bar;
        __builtin_amdgcn_s_waitcnt(0);
        unsigned nloc = b.st[0], nx = b.st[1];
        if (nloc == 0u) { xcd_barrier_complete(bar, b.x, nloc, nx); b.st[0] = nloc; b.st[1] = nx; }
        const unsigned old = xb_add(&bar[XB_XSUB(b.x)], 1u);
        const unsigned gen = old / nloc;
        if (old + 1u == (gen + 1u) * nloc) {
            __builtin_amdgcn_fence(__ATOMIC_RELEASE, "agent");
            asm volatile("s_waitcnt vmcnt(0)" ::: "memory");
            const unsigned og = xb_add(&bar[XB_TOP], 1u);
            const unsigned tg = og / nx;
            if (og + 1u == (tg + 1u) * nx) xb_add(&bar[XB_TOPGEN], 1u);
            else XB_SPIN(xb_ld(&bar[XB_TOPGEN]) == tg, bar);
            __builtin_amdgcn_fence(__ATOMIC_ACQUIRE, "agent");
            xb_add(&bar[XB_XGEN(b.x)], 1u);
            asm volatile("s_waitcnt vmcnt(0)" ::: "memory");
        } else {
            XB_SPIN(xb_ld(&bar[XB_XGEN(b.x)]) == gen, bar);
            __builtin_amdgcn_fence(__ATOMIC_ACQUIRE, "agent");
            asm volatile("s_waitcnt vmcnt(0)" ::: "memory");
        }
    }
    __syncthreads();
}

struct Frame {
    LAS unsigned char* lds; volatile LAS unsigned* MISC; gu32* ctl;
    int tid, lane, wave, vcu, G;
};
struct Args { const float* in[24]; float* out; unsigned char* ws; int ph_lo, ph_hi; };

__device__ __forceinline__ void p0_transpose_item(const float* W, int K, int N, bf16* WT, int k0, int n0, int drow0, LAS float* scr, int lane) {
#pragma unroll 8
    for (int i = 0; i < 32; ++i) { const int kk = 2 * i + (lane >> 5); scr[kk * 33 + (lane & 31)] = W[(size_t)(k0 + kk) * N + n0 + (lane & 31)]; }
    LDS_WAIT(); asm volatile("" ::: "memory");
    const int c = lane & 7;
#pragma unroll
    for (int j = 0; j < 4; ++j) { const int n = (lane >> 3) + 8 * j; const LAS float* s = scr + (8 * c) * 33 + n;
        u32x4 o; o.x = cvt_pk_bf16(s[0 * 33], s[1 * 33]); o.y = cvt_pk_bf16(s[2 * 33], s[3 * 33]); o.z = cvt_pk_bf16(s[4 * 33], s[5 * 33]); o.w = cvt_pk_bf16(s[6 * 33], s[7 * 33]);
        *(GAS u32x4*)(WT + (size_t)(drow0 + n) * K + k0 + 8 * c) = o; }
    LDS_WAIT(); asm volatile("" ::: "memory");
}
__device__ __forceinline__ void p0_transpose_item_fp8(const float* W, int K, int N, unsigned char* WT8, int k0, int n0, int drow0, LAS float* scr, int lane, float scale) {
#pragma unroll 8
    for (int i = 0; i < 32; ++i) { const int kk = 2 * i + (lane >> 5); scr[kk * 33 + (lane & 31)] = W[(size_t)(k0 + kk) * N + n0 + (lane & 31)]; }
    LDS_WAIT(); asm volatile("" ::: "memory");
    const int c = lane & 7;
#pragma unroll
    for (int j = 0; j < 4; ++j) { const int n = (lane >> 3) + 8 * j; const LAS float* s = scr + (8 * c) * 33 + n;
        u32x2 o; o.x = pk4_fp8(s[0 * 33] * scale, s[1 * 33] * scale, s[2 * 33] * scale, s[3 * 33] * scale); o.y = pk4_fp8(s[4 * 33] * scale, s[5 * 33] * scale, s[6 * 33] * scale, s[7 * 33] * scale);
        *(GAS u32x2*)(WT8 + (size_t)(drow0 + n) * K + k0 + 8 * c) = o; }
    LDS_WAIT(); asm volatile("" ::: "memory");
}
__device__ __forceinline__ void ln_row_to_bf16(const float* xrow, const float* g, const float* b, bf16* orow, int lane) {
    const GAS f32x4* xr = (const GAS f32x4*)xrow + lane;
    f32x4 v[4]; float s = 0.f;
#pragma unroll
    for (int j = 0; j < 4; ++j) { v[j] = xr[64 * j]; s += (v[j].x + v[j].y) + (v[j].z + v[j].w); }
    const float mean = wave_sum(s) * (1.f / DM); float s2 = 0.f;
#pragma unroll
    for (int j = 0; j < 4; ++j) { v[j] = v[j] - mean; s2 += (v[j].x * v[j].x + v[j].y * v[j].y) + (v[j].z * v[j].z + v[j].w * v[j].w); }
    const float rstd = 1.f / sqrtf(wave_sum(s2) * (1.f / DM) + LN_EPS);
    GAS u32x2* o8 = (GAS u32x2*)orow + lane;
#pragma unroll
    for (int j = 0; j < 4; ++j) { const f32x4 gg = *((const GAS f32x4*)g + lane + 64 * j), bb = *((const GAS f32x4*)b + lane + 64 * j);
        const f32x4 y = v[j] * rstd * gg + bb; u32x2 w; w.x = cvt_pk_bf16(y.x, y.y); w.y = cvt_pk_bf16(y.z, y.w); o8[64 * j] = w; }
}

namespace att {
constexpr int STG = 32768;
constexpr int LDS_WS = LDSCTL_OFF + 2048;
__device__ __forceinline__ void glds16(const void* gsrc, unsigned lds_dst) { unsigned keep;
    asm volatile("s_mov_b32 %0, m0\n\ts_mov_b32 m0, %2\n\ts_nop 0\n\tglobal_load_lds_dwordx4 %1, off\n\ts_mov_b32 m0, %0" : "=&s"(keep) : "v"(gsrc), "s"(lds_dst) : "memory"); }
__device__ __forceinline__ int crow(int r, int hi) { return (r & 3) + 8 * (r >> 2) + 4 * hi; }
__device__ __forceinline__ float swapmax(float m) { auto rr = __builtin_amdgcn_permlane32_swap(__float_as_uint(m), __float_as_uint(m), false, false); return fmaxf(__uint_as_float(rr[0]), __uint_as_float(rr[1])); }
__device__ __forceinline__ float swapsum(float m) { auto rr = __builtin_amdgcn_permlane32_swap(__float_as_uint(m), __float_as_uint(m), false, false); return __uint_as_float(rr[0]) + __uint_as_float(rr[1]); }
__device__ __forceinline__ s16x4 vtr(const LAS unsigned char* p) { typedef short v4i16_t __attribute__((ext_vector_type(4))); return __builtin_bit_cast(s16x4, __builtin_amdgcn_ds_read_tr16_b64_v4i16((LAS v4i16_t*)p)); }
}

__global__ void __launch_bounds__(NWAVES * 64, 2) hymba_fwd(Args args) {
    extern __shared__ __attribute__((aligned(16))) unsigned char lds_raw[];
    Frame F;
    F.lds = (LAS unsigned char*)lds_raw;
    F.MISC = (volatile LAS unsigned*)(F.lds + MISC_OFF);
    F.tid = threadIdx.x; F.lane = F.tid & 63; F.wave = __builtin_amdgcn_readfirstlane(F.tid >> 6);
    F.G = gridDim.x; { const int bx = blockIdx.x; F.vcu = (F.G % 8 == 0) ? (bx % 8) * (F.G / 8) + bx / 8 : bx; }
    unsigned char* ws = args.ws;
    F.ctl = (gu32*)(ws + WS_CTL);
    for (int u = F.tid; u < (LDS_BYTES - LDSCTL_OFF) / 4; u += NWAVES * 64) ((LAS unsigned*)(F.lds + LDSCTL_OFF))[u] = 0u;
    __syncthreads();
    XcdBarrier bar; bar.bar = (unsigned*)(F.ctl + CW_BAR); bar.x = 0; bar.st = nullptr;
    if (MK_N_LAUNCHES == 1) bar = xcd_barrier_post((unsigned*)(F.ctl + CW_BAR), F.MISC + 8);
    const int lo = args.ph_lo, hi = args.ph_hi;
#ifndef PH_MASK
#define PH_MASK 0xff
#endif
#define IN(k) (((PH_MASK >> (k)) & 1) && lo <= (k) && (k) < hi)
#define BOTH(k) (IN(k) && IN((k) + 1))
#ifndef REP_MASK
#define REP_MASK 0
#endif
#define NREP(k) (((REP_MASK >> (k)) & 1) ? 2 : 1)
#define GRID_BAR() do { xcd_barrier(bar); } while (0)
    const int lane = F.lane, wave = F.wave, tid = F.tid;
    const int gw = F.vcu * NWAVES + wave, NGW = F.G * NWAVES;

    const float* x_in = args.in[0];
    bf16* Win_t = (bf16*)(ws + WS_WIN); bf16* Wout_t = (bf16*)(ws + WS_WOUT); unsigned char* Wgu_t = ws + WS_WGU; unsigned char* Wd_t = ws + WS_WD;
    bf16* XN = (bf16*)(ws + WS_XN); bf16* Qb = (bf16*)(ws + WS_Q); bf16* Kb = (bf16*)(ws + WS_K); bf16* Vb = (bf16*)(ws + WS_V); bf16* HG = (bf16*)(ws + WS_HG);
    bf16* AC = (bf16*)(ws + WS_AC); float* Y1 = (float*)(ws + WS_Y1); bf16* X1 = (bf16*)(ws + WS_X1); unsigned char* HID = ws + WS_HID; bf16* YP = (bf16*)(ws + WS_YP); unsigned char* X1Q = ws + WS_X1Q;
    int* LIST = (int*)(ws + WS_LIST); float* GATEW = (float*)(ws + WS_GATE);

    if (IN(0)) {
      for (int rep_ = 0; rep_ < NREP(0); ++rep_) {
        LAS float* scr = (LAS float*)(F.lds + RING_OFF + wave * 16384);
        constexpr int I_IN = 16 * (IN_COLS / 32), I_OUT = 16 * 32, I_GU = 16 * 64, I_D = 16 * 32;
        constexpr int NITEMS = I_IN + I_OUT + NEXP * I_GU + NEXP * I_D;
        struct TItem { const float* W; unsigned char* dst; int N, k0, n0, drow0, fp8; };
        auto decode = [&](int it) -> TItem {
            TItem ti; int r = it;
            if (r < I_IN) { const int nblk = IN_COLS / 32, kb = r / nblk, nb = r % nblk, n0 = 32 * nb; int d;
                if (n0 < 1536) d = n0; else { const int j = n0 - 1536, g = j >= 512, ch = j & 511; d = 1536 + (ch >> 7) * 256 + g * 128 + (ch & 127); }
                ti.W = args.in[3]; ti.dst = (unsigned char*)Win_t; ti.N = IN_COLS; ti.k0 = 64 * kb; ti.n0 = n0; ti.drow0 = d; ti.fp8 = 0; return ti; }
            r -= I_IN;
            if (r < I_OUT) { const int kb = r / 32, nb = r % 32; ti.W = args.in[13]; ti.dst = (unsigned char*)Wout_t; ti.N = DM; ti.k0 = 64 * kb; ti.n0 = 32 * nb; ti.drow0 = 32 * nb; ti.fp8 = 0; return ti; }
            r -= I_OUT;
            if (r < NEXP * I_GU) { const int e = r / I_GU, q = r % I_GU, kb = q / 64, nb = q % 64, n0 = 32 * nb, g = n0 >= 1024, ch = n0 & 1023, d = (ch >> 7) * 256 + g * 128 + (ch & 127);
                ti.W = args.in[18] + (size_t)e * DM * 2048; ti.dst = Wgu_t + (size_t)e * 2048 * DM; ti.N = 2048; ti.k0 = 64 * kb; ti.n0 = n0; ti.drow0 = d; ti.fp8 = 1; return ti; }
            r -= NEXP * I_GU;
            { const int e = r / I_D, q = r % I_D, kb = q / 32, nb = q % 32;
                ti.W = args.in[20] + (size_t)e * DFF * DM; ti.dst = Wd_t + (size_t)e * DM * DFF; ti.N = DM; ti.k0 = 64 * kb; ti.n0 = 32 * nb; ti.drow0 = 32 * nb; ti.fp8 = 1; return ti; }
        };
        const int kr = lane >> 3, c4 = lane & 7;
        f32x4 tv[8], tn[8];
        TItem cur_i, nxt_i;
        int it = gw;
        if (it < NITEMS) { cur_i = decode(it);
#pragma unroll
            for (int i = 0; i < 8; ++i) tv[i] = __builtin_nontemporal_load((const GAS f32x4*)(cur_i.W + (size_t)(cur_i.k0 + kr + 8 * i) * cur_i.N + cur_i.n0 + 4 * c4)); }
        for (; it < NITEMS; it += NGW) {
            const bool has_n = it + NGW < NITEMS;
            if (has_n) { nxt_i = decode(it + NGW);
#pragma unroll
                for (int i = 0; i < 8; ++i) tn[i] = __builtin_nontemporal_load((const GAS f32x4*)(nxt_i.W + (size_t)(nxt_i.k0 + kr + 8 * i) * nxt_i.N + nxt_i.n0 + 4 * c4)); }
#pragma unroll
            for (int i = 0; i < 8; ++i) { LAS float* sp = scr + (kr + 8 * i) * 33 + 4 * c4; sp[0] = tv[i][0]; sp[1] = tv[i][1]; sp[2] = tv[i][2]; sp[3] = tv[i][3]; }
            LDS_WAIT(); asm volatile("" ::: "memory");
            { const int c = lane & 7;
#pragma unroll
              for (int j = 0; j < 4; ++j) { const int n = (lane >> 3) + 8 * j; const LAS float* sq = scr + (8 * c) * 33 + n;
                  if (cur_i.fp8) { u32x2 o; o.x = pk4_fp8(sq[0 * 33] * SW8, sq[1 * 33] * SW8, sq[2 * 33] * SW8, sq[3 * 33] * SW8); o.y = pk4_fp8(sq[4 * 33] * SW8, sq[5 * 33] * SW8, sq[6 * 33] * SW8, sq[7 * 33] * SW8);
                      __builtin_nontemporal_store(o, (GAS u32x2*)(cur_i.dst + (size_t)(cur_i.drow0 + n) * DM + cur_i.k0 + 8 * c)); }
                  else { u32x4 o; o.x = cvt_pk_bf16(sq[0 * 33], sq[1 * 33]); o.y = cvt_pk_bf16(sq[2 * 33], sq[3 * 33]); o.z = cvt_pk_bf16(sq[4 * 33], sq[5 * 33]); o.w = cvt_pk_bf16(sq[6 * 33], sq[7 * 33]);
                      *(GAS u32x4*)((bf16*)cur_i.dst + (size_t)(cur_i.drow0 + n) * DM + cur_i.k0 + 8 * c) = o; } } }
            LDS_WAIT(); asm volatile("" ::: "memory");
            if (has_n) { cur_i = nxt_i;
#pragma unroll
                for (int i = 0; i < 8; ++i) tv[i] = tn[i]; }
        }
        {
            f32x4 g0v[4], b0v[4], cv[4], nv[4];
#pragma unroll
            for (int j = 0; j < 4; ++j) { g0v[j] = *((const GAS f32x4*)args.in[1] + lane + 64 * j); b0v[j] = *((const GAS f32x4*)args.in[2] + lane + 64 * j); }
            if (gw < NTOK) {
#pragma unroll
                for (int j = 0; j < 4; ++j) cv[j] = __builtin_nontemporal_load((const GAS f32x4*)(x_in + (size_t)gw * DM) + lane + 64 * j); }
            for (int m = gw; m < NTOK; m += NGW) {
                if (m + NGW < NTOK) {
#pragma unroll
                    for (int j = 0; j < 4; ++j) nv[j] = __builtin_nontemporal_load((const GAS f32x4*)(x_in + (size_t)(m + NGW) * DM) + lane + 64 * j); }
                float s = 0.f;
#pragma unroll
                for (int j = 0; j < 4; ++j) s += (cv[j].x + cv[j].y) + (cv[j].z + cv[j].w);
                const float mean = wave_sum(s) * (1.f / DM); float s2 = 0.f;
#pragma unroll
                for (int j = 0; j < 4; ++j) { cv[j] = cv[j] - mean; s2 += (cv[j].x * cv[j].x + cv[j].y * cv[j].y) + (cv[j].z * cv[j].z + cv[j].w * cv[j].w); }
                const float rstd = 1.f / sqrtf(wave_sum(s2) * (1.f / DM) + LN_EPS);
                GAS u32x2* o8 = (GAS u32x2*)(XN + (size_t)m * DM) + lane;
#pragma unroll
                for (int j = 0; j < 4; ++j) { const f32x4 y = cv[j] * rstd * g0v[j] + b0v[j]; u32x2 w; w.x = cvt_pk_bf16(y.x, y.y); w.y = cvt_pk_bf16(y.z, y.w); o8[64 * j] = w; }
#pragma unroll
                for (int j = 0; j < 4; ++j) cv[j] = nv[j];
            }
        }
        __syncthreads();
      }
        if (BOTH(0)) GRID_BAR();
    }

    if (IN(1)) {
        pg8::DenseOrder S; S.init(NTOK, IN_COLS, F.G, (int)blockIdx.x, Win_t);
        static_assert(WS_K - WS_Q == WS_V - WS_K && WS_HG - WS_V == WS_K - WS_Q, "Q|K|V|HG equally spaced");
        pg8::EpiIn E{Qb, (size_t)(WS_K - WS_Q) / 2};
        pg8::gemm_phase<pg8::EpiIn, pg8::DenseOrder>(F.lds + RING_OFF, (const char*)XN, S, E);
        if (NREP(1) == 2) { pg8::gemm_phase<pg8::EpiIn, pg8::DenseOrder>(F.lds + RING_OFF, (const char*)XN, S, E); }
        if (BOTH(1)) GRID_BAR();
    }

    if (IN(2)) {
        using namespace att;
      for (int rep_ = 0; rep_ < NREP(2); ++rep_) {
#ifndef NO_ATTN
        for (int rep8_ = 0; rep8_ < NREP(8); ++rep8_)
        for (int un = F.vcu; un < 256; un += F.G)
        for (int ui = 0; ui < 2; ++ui) {
            const int bh = un >> 3, jj = un & 7, j = ui == 0 ? 15 - jj : jj, b = bh >> 2, h = bh & 3;
            const int r32 = lane & 31, hi = lane >> 5;
            const int comp = wave >> 2, qi = wave & 3;
            const int p = 4 * j + qi;
            const int dt = p >> 1;
            const int T = 2 * j + 2;
            const size_t rowbase = (size_t)b * SEQ;
            const int q = 32 * p + r32;
            const float sl2 = LOG2E * (h == 0 ? 0.25f : h == 1 ? 0.0625f : h == 2 ? 0.015625f : 0.00390625f);
            bf16x8 qr[4];
#pragma unroll
            for (int d0 = 0; d0 < 4; ++d0) qr[d0] = *(const bf16x8*)(Qb + (rowbase + 32 * p + r32) * AW + h * 128 + comp * 64 + d0 * 16 + hi * 8);
            f32x16 o[4];
#pragma unroll
            for (int db = 0; db < 4; ++db)
#pragma unroll
                for (int r = 0; r < 16; ++r) o[db][r] = 0.f;
            float mrun = -1.0e30f, lrun = 0.f;
            LAS float* wsf = (LAS float*)(F.lds + LDS_WS) + wave * 128;
            unsigned ksrc[2], vsrc[2];
#pragma unroll
            for (int i = 0; i < 2; ++i) { const int pc = 2 * wave + i;
                { const int kc = pc >> 3, krow = (pc & 7) * 8 + (lane >> 3), kch = (lane & 7) ^ ((krow >> 1) & 7);
                  ksrc[i] = (unsigned)((rowbase + krow) * AW + h * 128 + kc * 64 + kch * 8); }
                vsrc[i] = (unsigned)((rowbase + (pc & 3) * 16 + (lane >> 2)) * AW + h * 128 + (pc >> 2) * 32 + (lane & 3) * 8); }
            const unsigned ldsb = (unsigned)(size_t)(F.lds + RING_OFF) + (unsigned)(2 * wave) * 1024u;
#define ATT_ISSUE(t, st) do { _Pragma("unroll") for (int _i = 0; _i < 2; ++_i) { \
                glds16(Kb + ksrc[_i] + (size_t)(t) * 64 * AW, (unsigned)__builtin_amdgcn_readfirstlane(ldsb + (st) * STG + _i * 1024)); \
                glds16(Vb + vsrc[_i] + (size_t)(t) * 64 * AW, (unsigned)__builtin_amdgcn_readfirstlane(ldsb + (st) * STG + 16384 + _i * 1024)); } } while (0)
#pragma unroll
            for (int d0 = 0; d0 < 4; ++d0) asm volatile("" : "+v"(qr[d0]));
            const int vlane = ((lane >> 4) & 1) * 32 + (lane & 3) * 8 + (4 * hi + ((lane & 15) >> 2)) * 64;
            bf16x8 pa[4];
#pragma unroll
            for (int k = 0; k < 4; ++k) pa[k] = (bf16x8){0, 0, 0, 0, 0, 0, 0, 0};
            ATT_ISSUE(T - 1, 0);
            ATT_ISSUE(T - 2, 1);
            asm volatile("s_waitcnt vmcnt(4)" ::: "memory");
            asm volatile("s_waitcnt lgkmcnt(0)\n\ts_barrier" ::: "memory");
            if (comp == 1) asm volatile("s_barrier" ::: "memory");
            int sc = 0, sprev = 0;
            for (int it = 0; it < T; ++it) {
                const int t = T - 1 - it;
                const int sn = (sc == 2) ? 0 : sc + 1;
                if (comp == 0 && it >= 1 && it + 1 < T) ATT_ISSUE(t - 1, sn);
                f32x16 p0, p1;
                {
                    const LAS unsigned char* Ks = F.lds + RING_OFF + sc * STG;
                    const LAS unsigned char* Vs = F.lds + RING_OFF + sprev * STG + 16384;
                    bf16x8 kf[8]; s16x4 vA[16], vB[16];
#pragma unroll
                    for (int d0 = 0; d0 < 4; ++d0) { const LAS unsigned char* kb = Ks + comp * 8192 + (r32 >> 3) * 1024 + (r32 & 7) * 128 + (((2 * d0 + hi) ^ ((r32 >> 1) & 7)) * 16);
                        kf[2 * d0] = *(const LAS bf16x8*)kb; kf[2 * d0 + 1] = *(const LAS bf16x8*)(kb + 4096); }
#pragma unroll
                    for (int i = 0; i < 8; ++i) { const LAS unsigned char* vp = Vs + i * 1024 + vlane; vA[2 * i] = vtr(vp); vA[2 * i + 1] = vtr(vp + 512); }
                    float sl2v = sl2; asm volatile("" : "+v"(sl2v));
                    const float fb = sl2v * (float)(64 * t + 4 * hi - q);
#pragma unroll
                    for (int r = 0; r < 16; ++r) { p0[r] = fb + sl2v * (float)((r & 3) + 8 * (r >> 2)); p1[r] = p0[r] + 32.0f * sl2v; }
                    __builtin_amdgcn_sched_barrier(0);
#pragma unroll
                    for (int d0 = 0; d0 < 4; ++d0) {
                        p0 = __builtin_amdgcn_mfma_f32_32x32x16_bf16(kf[2 * d0], qr[d0], p0, 0, 0, 0);
                        p1 = __builtin_amdgcn_mfma_f32_32x32x16_bf16(kf[2 * d0 + 1], qr[d0], p1, 0, 0, 0);
                    }
                    __builtin_amdgcn_sched_barrier(0);
#pragma unroll
                    for (int i = 0; i < 8; ++i) { const LAS unsigned char* vp = Vs + (8 + i) * 1024 + vlane; vB[2 * i] = vtr(vp); vB[2 * i + 1] = vtr(vp + 512); }
#pragma unroll
                    for (int db = 0; db < 2; ++db)
#pragma unroll
                        for (int ks = 0; ks < 4; ++ks) { const int i = db * 4 + ks; const s16x4 vl = vA[2 * i], vh = vA[2 * i + 1];
                            o[db] = __builtin_amdgcn_mfma_f32_32x32x16_bf16(pa[ks], (bf16x8){vl[0], vl[1], vl[2], vl[3], vh[0], vh[1], vh[2], vh[3]}, o[db], 0, 0, 0); }
                    __builtin_amdgcn_sched_barrier(0);
#pragma unroll
                    for (int db = 2; db < 4; ++db)
#pragma unroll
                        for (int ks = 0; ks < 4; ++ks) { const int i = (db - 2) * 4 + ks; const s16x4 vl = vB[2 * i], vh = vB[2 * i + 1];
                            o[db] = __builtin_amdgcn_mfma_f32_32x32x16_bf16(pa[ks], (bf16x8){vl[0], vl[1], vl[2], vl[3], vh[0], vh[1], vh[2], vh[3]}, o[db], 0, 0, 0); }
                    __builtin_amdgcn_sched_barrier(0);
                }
                if (comp == 1) asm volatile("s_waitcnt vmcnt(0)" ::: "memory");
                asm volatile("s_waitcnt lgkmcnt(0)\n\ts_barrier" ::: "memory");
                if (comp == 1 && it + 2 < T) ATT_ISSUE(t - 2, (sn == 2) ? 0 : sn + 1);
                {
                    if (t >= dt) {
                        const int kb0 = 64 * t + 4 * hi - q;
#pragma unroll
                        for (int r = 0; r < 16; ++r) { const int rel = kb0 + (r & 3) + 8 * (r >> 2); if (rel > 0) p0[r] = -INFINITY; if (rel + 32 > 0) p1[r] = -INFINITY; }
                    }
                    float rm = fmaxf(p0[0], p1[0]);
#pragma unroll
                    for (int r = 1; r < 16; ++r) rm = fmaxf(rm, fmaxf(p0[r], p1[r]));
                    rm = swapmax(rm);
                    const float mn = fmaxf(mrun, rm);
                    if (__any(rm > mrun + 8.0f)) {
                        const float f = fast_exp2(mrun - mn);
                        lrun *= f; mrun = mn;
                        if (hi == 0) wsf[r32] = f;
                        LDS_WAIT();
#pragma unroll
                        for (int r = 0; r < 16; ++r) { const float fr_ = wsf[crow(r, hi)];
#pragma unroll
                            for (int db = 0; db < 4; ++db) o[db][r] *= fr_; }
                        LDS_WAIT();
                    }
                    float ls = 0.f;
#pragma unroll
                    for (int r = 0; r < 16; ++r) { p0[r] = fast_exp2(p0[r] - mrun); p1[r] = fast_exp2(p1[r] - mrun); ls += p0[r] + p1[r]; }
                    lrun += ls;
                    u32x4 w0, w1, w2, w3;
                    w0.x = cvt_pk_bf16(p0[0], p0[1]); w0.y = cvt_pk_bf16(p0[2], p0[3]); w0.z = cvt_pk_bf16(p0[4], p0[5]); w0.w = cvt_pk_bf16(p0[6], p0[7]);
                    w1.x = cvt_pk_bf16(p0[8], p0[9]); w1.y = cvt_pk_bf16(p0[10], p0[11]); w1.z = cvt_pk_bf16(p0[12], p0[13]); w1.w = cvt_pk_bf16(p0[14], p0[15]);
                    w2.x = cvt_pk_bf16(p1[0], p1[1]); w2.y = cvt_pk_bf16(p1[2], p1[3]); w2.z = cvt_pk_bf16(p1[4], p1[5]); w2.w = cvt_pk_bf16(p1[6], p1[7]);
                    w3.x = cvt_pk_bf16(p1[8], p1[9]); w3.y = cvt_pk_bf16(p1[10], p1[11]); w3.z = cvt_pk_bf16(p1[12], p1[13]); w3.w = cvt_pk_bf16(p1[14], p1[15]);
                    pa[0] = __builtin_bit_cast(bf16x8, w0); pa[1] = __builtin_bit_cast(bf16x8, w1); pa[2] = __builtin_bit_cast(bf16x8, w2); pa[3] = __builtin_bit_cast(bf16x8, w3);
                }
                if (comp == 0) asm volatile("s_waitcnt vmcnt(0)" ::: "memory");
                asm volatile("s_waitcnt lgkmcnt(0)\n\ts_barrier" ::: "memory");
                sprev = sc; sc = sn;
            }
            {
                const LAS unsigned char* Vs = F.lds + RING_OFF + sprev * STG + 16384;
#pragma unroll
                for (int db = 0; db < 4; ++db)
#pragma unroll
                    for (int ks = 0; ks < 4; ++ks) { const LAS unsigned char* vp = Vs + (db * 4 + ks) * 1024 + vlane; const s16x4 vl = vtr(vp), vh = vtr(vp + 512);
                        o[db] = __builtin_amdgcn_mfma_f32_32x32x16_bf16(pa[ks], (bf16x8){vl[0], vl[1], vl[2], vl[3], vh[0], vh[1], vh[2], vh[3]}, o[db], 0, 0, 0); }
            }
            if (comp == 0) asm volatile("s_barrier" ::: "memory");
#undef ATT_ISSUE
            asm volatile("s_waitcnt lgkmcnt(0)\n\ts_barrier" ::: "memory");
            {
                int lane_o = lane; asm volatile("" : "+v"(lane_o));
                const int r32o = lane_o & 31, hio = lane_o >> 5;
                LAS float* wsf2 = (LAS float*)(F.lds + LDS_WS) + wave * 128;
                LAS float* XB = (LAS float*)(F.lds + RING_OFF) + qi * 4096 + lane_o;
                const float linv = fast_rcp(swapsum(lrun));
                if (comp == 1) {
                    float lam;
                    { const float a = args.in[4][lane_o] * args.in[5][lane_o], bb2 = args.in[6][lane_o] * args.in[7][lane_o];
                      lam = __expf(wave_sum(a)) - __expf(wave_sum(bb2)) + LAMBDA_INIT; }
                    if (hio == 0) wsf2[r32o] = lam * linv;
                    LDS_WAIT();
#pragma unroll
                    for (int r = 0; r < 16; ++r) { const float a1 = wsf2[crow(r, hio)];
#pragma unroll
                        for (int db = 0; db < 4; ++db) XB[(db * 16 + r) * 64] = o[db][r] * a1; }
                }
                asm volatile("s_waitcnt lgkmcnt(0)\n\ts_barrier" ::: "memory");
                if (comp == 0) {
                    if (hio == 0) wsf2[r32o] = linv;
                    LDS_WAIT();
                    float gsub[4];
#pragma unroll
                    for (int db = 0; db < 4; ++db) gsub[db] = args.in[8][db * 32 + r32o] * (1.0f - LAMBDA_INIT);
#pragma unroll
                    for (int r = 0; r < 16; ++r) {
                        const int qq = crow(r, hio); const float a0 = wsf2[qq];
                        float v[4], ss = 0.f;
#pragma unroll
                        for (int db = 0; db < 4; ++db) { v[db] = o[db][r] * a0 - XB[(db * 16 + r) * 64]; ss += v[db] * v[db]; }
                        ss += __shfl_xor(ss, 1); ss += __shfl_xor(ss, 2); ss += __shfl_xor(ss, 4); ss += __shfl_xor(ss, 8); ss += __shfl_xor(ss, 16);
                        const float rs = 1.0f / sqrtf(ss * (1.0f / 128.0f) + LN_EPS);
                        bf16* op = AC + (rowbase + 32 * p + qq) * DM + h * 128 + r32o;
#pragma unroll
                        for (int db = 0; db < 4; ++db) op[db * 32] = (bf16)(cvt_pk_bf16(v[db] * rs * gsub[db], 0.f) & 0xffffu);
                    }
                }
            }
            asm volatile("s_waitcnt lgkmcnt(0)\n\ts_barrier" ::: "memory");
        }
#endif
#ifndef NO_CONV
        {
            LAS float* WP = (LAS float*)(F.lds + RING_OFF);
            for (int idx = tid; idx < 47 * 512; idx += NWAVES * 64) { const int jj = idx >> 9, ch = idx & 511, j = jj - 7; WP[idx] = (j >= 0 && j <= 30) ? args.in[9][j * 512 + ch] : 0.f; }
            __syncthreads();
            const int ch0 = lane * 8;
            for (int rep9_ = 0; rep9_ < NREP(9); ++rep9_)
            for (int item = gw; item < NTOK / 8; item += NGW) {
                const int t0 = item * 8, tpos = t0 & (SEQ - 1);
                float acc[8][8];
                { const f32x4 b0 = *(const f32x4*)(args.in[10] + ch0), b1 = *(const f32x4*)(args.in[10] + ch0 + 4);
#pragma unroll
                  for (int tt = 0; tt < 8; ++tt) { acc[tt][0] = b0[0]; acc[tt][1] = b0[1]; acc[tt][2] = b0[2]; acc[tt][3] = b0[3]; acc[tt][4] = b1[0]; acc[tt][5] = b1[1]; acc[tt][6] = b1[2]; acc[tt][7] = b1[3]; } }
                u32x4 cur[4], nxt[4];
                const bf16* hg0 = HG + (size_t)t0 * AW + ch0;
#pragma unroll
                for (int ii = 0; ii < 4; ++ii) { const bool ok_ = (tpos - 30 + ii >= 0); const u32x4 v_ = *(const u32x4*)(hg0 + (ok_ ? (ii - 30) * AW : 0)); cur[ii] = ok_ ? v_ : (u32x4){0u, 0u, 0u, 0u}; }
#pragma unroll 1
                for (int ck = 0; ck < 10; ++ck) {
#pragma unroll
                    for (int ii = 0; ii < 4; ++ii) { const int i_ = (ck + 1) * 4 + ii; const bool ok_ = (i_ < 38) && (tpos - 30 + i_ >= 0); const u32x4 v_ = *(const u32x4*)(hg0 + (ok_ ? (i_ - 30) * AW : 0)); nxt[ii] = ok_ ? v_ : (u32x4){0u, 0u, 0u, 0u}; }
                    const LAS float* wck = WP + ck * 4 * 512 + ch0;
#pragma unroll
                    for (int ii = 0; ii < 4; ++ii) {
                        const u32x4 hw = cur[ii];
                        float hv[8]; hv[0] = bf_lo(hw.x); hv[1] = bf_hi(hw.x); hv[2] = bf_lo(hw.y); hv[3] = bf_hi(hw.y); hv[4] = bf_lo(hw.z); hv[5] = bf_hi(hw.z); hv[6] = bf_lo(hw.w); hv[7] = bf_hi(hw.w);
                        const LAS float* wr_ = wck + ii * 512;
#pragma unroll
                        for (int tt = 0; tt < 8; ++tt) { const f32x4 w0 = *(const LAS f32x4*)(wr_ + (7 - tt) * 512), w1 = *(const LAS f32x4*)(wr_ + (7 - tt) * 512 + 4);
                            acc[tt][0] += w0[0] * hv[0]; acc[tt][1] += w0[1] * hv[1]; acc[tt][2] += w0[2] * hv[2]; acc[tt][3] += w0[3] * hv[3];
                            acc[tt][4] += w1[0] * hv[4]; acc[tt][5] += w1[1] * hv[5]; acc[tt][6] += w1[2] * hv[6]; acc[tt][7] += w1[3] * hv[7]; }
                    }
#pragma unroll
                    for (int ii = 0; ii < 4; ++ii) cur[ii] = nxt[ii];
                }
                const f32x4 g0 = *(const f32x4*)(args.in[11] + ch0), g1 = *(const f32x4*)(args.in[11] + ch0 + 4), c0 = *(const f32x4*)(args.in[12] + ch0), c1 = *(const f32x4*)(args.in[12] + ch0 + 4);
#pragma unroll
                for (int tt = 0; tt < 8; ++tt) {
                    float s = 0.f;
#pragma unroll
                    for (int k = 0; k < 8; ++k) s += acc[tt][k];
                    const float mean = wave_sum(s) * (1.0f / 512.0f); float s2 = 0.f;
#pragma unroll
                    for (int k = 0; k < 8; ++k) { acc[tt][k] -= mean; s2 += acc[tt][k] * acc[tt][k]; }
                    const float rstd = 1.0f / sqrtf(wave_sum(s2) * (1.0f / 512.0f) + LN_EPS);
                    float y[8];
#pragma unroll
                    for (int k = 0; k < 8; ++k) { const float gg = k < 4 ? g0[k & 3] : g1[k & 3], cc = k < 4 ? c0[k & 3] : c1[k & 3]; const float v = acc[tt][k] * rstd * gg + cc; y[k] = v * sigmoidf_(v); }
                    u32x4 w; w.x = cvt_pk_bf16(y[0], y[1]); w.y = cvt_pk_bf16(y[2], y[3]); w.z = cvt_pk_bf16(y[4], y[5]); w.w = cvt_pk_bf16(y[6], y[7]);
                    *(u32x4*)(AC + (size_t)(t0 + tt) * DM + 512 + ch0) = w;
                }
            }
            __syncthreads();
        }
#endif
      }
        if (BOTH(2)) GRID_BAR();
    }

    if (IN(3)) {
        pg8::DenseOrder S; S.init(NTOK, DM, F.G, (int)blockIdx.x, Wout_t);
        pg8::EpiOut E{Y1, XN};
        pg8::gemm_phase<pg8::EpiOut, pg8::DenseOrder>(F.lds + RING_OFF, (const char*)AC, S, E);
        if (NREP(3) == 2) { pg8::gemm_phase<pg8::EpiOut, pg8::DenseOrder>(F.lds + RING_OFF, (const char*)AC, S, E); }
        if (BOTH(3)) GRID_BAR();
    }

    if (IN(4)) {
        constexpr int XSTR = 1028;
        LAS float* XS = (LAS float*)(F.lds + RING_OFF);
        LAS float* PL = (LAS float*)(F.lds + RING_OFF + 65792);
        LAS float* LG = (LAS float*)(F.lds + RING_OFF + 82176);
        LAS int* SEL = (LAS int*)(F.lds + RING_OFF + 84224);
        LAS float* GT = (LAS float*)(F.lds + RING_OFF + 85248);
        LAS int* RK = (LAS int*)(F.lds + RING_OFF + 86272);
        LAS int* LCNT = (LAS int*)(F.lds + RING_OFF + 87296);
        LAS int* GBASE = (LAS int*)(F.lds + RING_OFF + 87424);
        if (tid < 32) LCNT[tid] = 0;
        float rwf[32][2];
#pragma unroll
        for (int s = 0; s < 32; ++s) { const int k = 128 * wave + 4 * s + (lane >> 4); rwf[s][0] = args.in[16][k * 32 + (lane & 15)]; rwf[s][1] = args.in[16][k * 32 + 16 + (lane & 15)]; }
        __syncthreads();
        int gi = 0;
        for (int rep10_ = 0; rep10_ < NREP(10); ++rep10_) {
        if (rep10_ == 1) { __syncthreads(); if (tid < 32) LCNT[tid] = 0; __syncthreads(); }
        gi = 0;
        f32x4 g1v[4], b1v[4];
#pragma unroll
        for (int j = 0; j < 4; ++j) { g1v[j] = *((const GAS f32x4*)args.in[14] + lane + 64 * j); b1v[j] = *((const GAS f32x4*)args.in[15] + lane + 64 * j); }
        f32x4 cvr[2][4], nvr[2][4];
        if ((int)blockIdx.x < NTOK / 16) {
#pragma unroll
            for (int rr = 0; rr < 2; ++rr)
#pragma unroll
                for (int j = 0; j < 4; ++j) cvr[rr][j] = __builtin_nontemporal_load((const GAS f32x4*)(Y1 + ((size_t)blockIdx.x * 16 + 2 * wave + rr) * DM) + lane + 64 * j); }
        for (int g = blockIdx.x; g < NTOK / 16; g += F.G, ++gi) {
            if (g + F.G < NTOK / 16) {
#pragma unroll
                for (int rr = 0; rr < 2; ++rr)
#pragma unroll
                    for (int j = 0; j < 4; ++j) nvr[rr][j] = __builtin_nontemporal_load((const GAS f32x4*)(Y1 + ((size_t)(g + F.G) * 16 + 2 * wave + rr) * DM) + lane + 64 * j); }
#pragma unroll
            for (int rr = 0; rr < 2; ++rr) {
                const int lr = 2 * wave + rr; const size_t row = (size_t)g * 16 + lr;
                f32x4 v[4]; float s = 0.f;
#pragma unroll
                for (int j = 0; j < 4; ++j) { v[j] = cvr[rr][j]; s += (v[j].x + v[j].y) + (v[j].z + v[j].w); }
                const float mean = wave_sum(s) * (1.f / DM); float s2 = 0.f;
#pragma unroll
                for (int j = 0; j < 4; ++j) { v[j] = v[j] - mean; s2 += (v[j].x * v[j].x + v[j].y * v[j].y) + (v[j].z * v[j].z + v[j].w * v[j].w); }
                const float rstd = 1.f / sqrtf(wave_sum(s2) * (1.f / DM) + LN_EPS);
                GAS u32x2* o8 = (GAS u32x2*)(X1 + row * DM) + lane;
#pragma unroll
                for (int j = 0; j < 4; ++j) { const f32x4 y = v[j] * rstd * g1v[j] + b1v[j]; u32x2 w; w.x = cvt_pk_bf16(y.x, y.y); w.y = cvt_pk_bf16(y.z, y.w); o8[64 * j] = w;
                    *((GAS unsigned*)(X1Q + row * DM) + lane + 64 * j) = pk4_fp8(y.x * SX8, y.y * SX8, y.z * SX8, y.w * SX8);
                    *(LAS f32x4*)(XS + lr * XSTR + 4 * lane + 256 * j) = y; }
#pragma unroll
                for (int j = 0; j < 4; ++j) cvr[rr][j] = nvr[rr][j];
            }
            __syncthreads();
            {
                f32x4 a0 = (f32x4){0.f, 0.f, 0.f, 0.f}, a1 = a0;
                const LAS float* xp = XS + (lane & 15) * XSTR + 128 * wave + (lane >> 4);
#pragma unroll
                for (int s = 0; s < 32; ++s) { const float a = xp[4 * s];
                    a0 = __builtin_amdgcn_mfma_f32_16x16x4f32(a, rwf[s][0], a0, 0, 0, 0);
                    a1 = __builtin_amdgcn_mfma_f32_16x16x4f32(a, rwf[s][1], a1, 0, 0, 0); }
#pragma unroll
                for (int r = 0; r < 4; ++r) { PL[(wave * 16 + 4 * (lane >> 4) + r) * 32 + (lane & 15)] = a0[r]; PL[(wave * 16 + 4 * (lane >> 4) + r) * 32 + 16 + (lane & 15)] = a1[r]; }
            }
            __syncthreads();
            {
                const int row = 2 * wave + (lane >> 5), e = lane & 31; float lg = args.in[17][e];
#pragma unroll
                for (int w = 0; w < 8; ++w) lg += PL[(w * 16 + row) * 32 + e];
                int se[4]; float sv[4];
#pragma unroll
                for (int k = 0; k < 4; ++k) { float bv = lg; int bi = e;
#pragma unroll
                    for (int off = 16; off >= 1; off >>= 1) { const float ov = __shfl_xor(bv, off); const int oi = __shfl_xor(bi, off); const bool take = (ov > bv) || (ov == bv && oi < bi); bv = take ? ov : bv; bi = take ? oi : bi; }
                    se[k] = bi; sv[k] = bv; if (e == bi) lg = -INFINITY; }
                float ex[4], es = 0.f;
#pragma unroll
                for (int k = 0; k < 4; ++k) { ex[k] = __expf(sv[k] - sv[0]); es += ex[k]; }
                const float inv = 1.0f / es; const int lrow = gi * 16 + row;
                if (e < 4) { const int ek = e == 0 ? se[0] : (e == 1 ? se[1] : (e == 2 ? se[2] : se[3])); const float gk = (e == 0 ? ex[0] : (e == 1 ? ex[1] : (e == 2 ? ex[2] : ex[3]))) * inv;
                    SEL[lrow * 4 + e] = ek; GT[lrow * 4 + e] = gk; RK[lrow * 4 + e] = atomicAdd((int*)&LCNT[ek], 1); }
            }
        }
        }
        __syncthreads();
        if (tid < 32) GBASE[tid] = (int)__hip_atomic_fetch_add(F.ctl + CW_GCNT + 64 * tid, (unsigned)LCNT[tid], RLX_AGENT);
        __syncthreads();
        if (tid < 256) {
            const int lrow = tid >> 2, k = tid & 3, gidx = lrow >> 4;
            if (gidx < gi) { const int g = blockIdx.x + gidx * F.G, token = g * 16 + (lrow & 15), p = token * 4 + k, e = SEL[lrow * 4 + k];
                LIST[e * LISTCAP + GBASE[e] + RK[lrow * 4 + k]] = p; GATEW[p] = GT[lrow * 4 + k]; }
        }
        __syncthreads();
        if (BOTH(4)) GRID_BAR();
    }

    if (IN(5) || IN(6)) {
        LAS int* TP = (LAS int*)(F.lds + MOE_TP_OFF); LAS int* CN = TP + 64;
        if (tid < 32) CN[tid] = (int)__hip_atomic_load(F.ctl + CW_GCNT + 64 * tid, RLX_AGENT);
        __syncthreads();
        if (tid == 0) { int a = 0; for (int e = 0; e < 32; ++e) { TP[e] = a; a += (CN[e] + 255) >> 8; } TP[32] = a; }
        __syncthreads();
    }
    if (IN(5)) {
        pg8::MoeOrder<8, true, 1024> S{(const LAS int*)(F.lds + MOE_TP_OFF), (const LAS int*)(F.lds + MOE_TP_OFF) + 64, F.G, F.vcu, lane, LIST, (const char*)Wgu_t, (size_t)2048 * DM};
        pg8::EpiSwiglu E{HID, args.in[19]};
        pg8::gemm_phase<pg8::EpiSwiglu, pg8::MoeOrder<8, true, 1024>, true>(F.lds + RING_OFF, (const char*)X1Q, S, E);
        if (NREP(5) == 2) { pg8::gemm_phase<pg8::EpiSwiglu, pg8::MoeOrder<8, true, 1024>, true>(F.lds + RING_OFF, (const char*)X1Q, S, E); }
        if (BOTH(5)) GRID_BAR();
    }
    if (IN(6)) {
        pg8::MoeOrder<4, false, 1024> S{(const LAS int*)(F.lds + MOE_TP_OFF), (const LAS int*)(F.lds + MOE_TP_OFF) + 64, F.G, F.vcu, lane, LIST, (const char*)Wd_t, (size_t)DM * DFF};
        pg8::EpiDown E{YP, args.in[21], LIST, GATEW};
        pg8::gemm_phase<pg8::EpiDown, pg8::MoeOrder<4, false, 1024>, true>(F.lds + RING_OFF, (const char*)HID, S, E);
        if (NREP(6) == 2) { pg8::gemm_phase<pg8::EpiDown, pg8::MoeOrder<4, false, 1024>, true>(F.lds + RING_OFF, (const char*)HID, S, E); }
        if (BOTH(6)) GRID_BAR();
    }
    if (IN(7)) {
        const unsigned bad = (MK_N_LAUNCHES == 1) ? __hip_atomic_load((gu32*)(F.ctl + CW_BAR + XB_TMO), RLX_AGENT) : 0u;
        f32x4 g2v[4], b2v[4];
#pragma unroll
        for (int j = 0; j < 2; ++j)
#pragma unroll
            for (int hh = 0; hh < 2; ++hh) { const int c0 = 8 * lane + 512 * j + 4 * hh; g2v[2 * j + hh] = *(const f32x4*)(args.in[22] + c0); b2v[2 * j + hh] = *(const f32x4*)(args.in[23] + c0); }
        for (int rep_ = 0; rep_ < NREP(7); ++rep_) {
        u32x4 cx[2], cy[8], nx[2], ny[8];
#define P7_LOAD(dx, dy, r_) do { _Pragma("unroll") for (int j = 0; j < 2; ++j) dx[j] = __builtin_nontemporal_load((const u32x4*)(X1 + (size_t)(r_) * DM + 8 * lane + 512 * j)); \
            _Pragma("unroll") for (int k = 0; k < 4; ++k) _Pragma("unroll") for (int j = 0; j < 2; ++j) dy[2 * k + j] = __builtin_nontemporal_load((const u32x4*)(YP + ((size_t)(r_) * 4 + k) * DM + 8 * lane + 512 * j)); } while (0)
        if (gw < NTOK) P7_LOAD(cx, cy, gw);
        for (int row = gw; row < NTOK; row += NGW) {
            if (row + NGW < NTOK) P7_LOAD(nx, ny, row + NGW);
            float v[16];
#pragma unroll
            for (int j = 0; j < 2; ++j) { const u32x4 xw = cx[j];
                v[8 * j + 0] = ALPHA * bf_lo(xw.x); v[8 * j + 1] = ALPHA * bf_hi(xw.x); v[8 * j + 2] = ALPHA * bf_lo(xw.y); v[8 * j + 3] = ALPHA * bf_hi(xw.y);
                v[8 * j + 4] = ALPHA * bf_lo(xw.z); v[8 * j + 5] = ALPHA * bf_hi(xw.z); v[8 * j + 6] = ALPHA * bf_lo(xw.w); v[8 * j + 7] = ALPHA * bf_hi(xw.w); }
#pragma unroll
            for (int k = 0; k < 4; ++k)
#pragma unroll
                for (int j = 0; j < 2; ++j) { const u32x4 yw = cy[2 * k + j];
                    v[8 * j + 0] += bf_lo(yw.x); v[8 * j + 1] += bf_hi(yw.x); v[8 * j + 2] += bf_lo(yw.y); v[8 * j + 3] += bf_hi(yw.y);
                    v[8 * j + 4] += bf_lo(yw.z); v[8 * j + 5] += bf_hi(yw.z); v[8 * j + 6] += bf_lo(yw.w); v[8 * j + 7] += bf_hi(yw.w); }
            float s = 0.f;
#pragma unroll
            for (int i = 0; i < 16; ++i) s += v[i];
            const float mean = wave_sum(s) * (1.f / DM); float s2 = 0.f;
#pragma unroll
            for (int i = 0; i < 16; ++i) { v[i] -= mean; s2 += v[i] * v[i]; }
            const float rstd = 1.f / sqrtf(wave_sum(s2) * (1.f / DM) + LN_EPS);
#pragma unroll
            for (int j = 0; j < 2; ++j)
#pragma unroll
                for (int hh = 0; hh < 2; ++hh) { const int c0 = 8 * lane + 512 * j + 4 * hh; const f32x4 gg = g2v[2 * j + hh], bb = b2v[2 * j + hh];
                    f32x4 o; o[0] = v[8 * j + 4 * hh + 0] * rstd * gg[0] + bb[0]; o[1] = v[8 * j + 4 * hh + 1] * rstd * gg[1] + bb[1]; o[2] = v[8 * j + 4 * hh + 2] * rstd * gg[2] + bb[2]; o[3] = v[8 * j + 4 * hh + 3] * rstd * gg[3] + bb[3];
                    if (bad) { const float qn = __builtin_nanf(""); o = (f32x4){qn, qn, qn, qn}; }
                    __builtin_nontemporal_store(o, (f32x4*)(args.out + (size_t)row * DM + c0)); }
#pragma unroll
            for (int j = 0; j < 2; ++j) cx[j] = nx[j];
#pragma unroll
            for (int k = 0; k < 8; ++k) cy[k] = ny[k];
        }
#undef P7_LOAD
        }
    }
#undef IN
#undef BOTH
#undef GRID_BAR
}

extern "C" void kernel_launch(void* const* d_in, const int* in_sizes, int n_in, void* d_out, int out_size, void* d_ws, size_t ws_size, hipStream_t stream) {
    static int grid = 0;
    if (grid == 0) {
        if (n_in != 24 || in_sizes[0] != NTOK * DM || out_size != NTOK * DM || ws_size < WS_END) { fprintf(stderr, "kernel_launch: unexpected shapes (n_in %d, in0 %d, out %d, ws %zu); nothing launched\n", n_in, n_in > 0 ? in_sizes[0] : -1, out_size, ws_size); grid = -1; return; }
        int dev = 0, cus = 0, per_cu = 0;
        if (hipGetDevice(&dev) != hipSuccess || hipDeviceGetAttribute(&cus, hipDeviceAttributeMultiprocessorCount, dev) != hipSuccess) { grid = -1; return; }
        if (hipFuncSetAttribute((const void*)hymba_fwd, hipFuncAttributeMaxDynamicSharedMemorySize, LDS_BYTES) != hipSuccess) { fprintf(stderr, "kernel_launch: hipFuncSetAttribute failed\n"); grid = -1; return; }
        if (hipOccupancyMaxActiveBlocksPerMultiprocessor(&per_cu, (const void*)hymba_fwd, NWAVES * 64, LDS_BYTES) != hipSuccess || per_cu < 1)
            fprintf(stderr, "kernel_launch: note: occupancy query reports %d workgroups per CU\n", per_cu);
        (void)hipGetLastError();
        grid = cus;
        if (grid != 256) fprintf(stderr, "kernel_launch: %d CUs; this kernel is laid out for 256\n", grid);
    }
    if (grid < 0) return;
    (void)hipMemsetAsync((char*)d_ws + WS_CTL, 0, CTL_ZERO_BYTES, stream);
    Args a{};
    for (int i = 0; i < 24; ++i) a.in[i] = (const float*)d_in[i];
    a.out = (float*)d_out; a.ws = (unsigned char*)d_ws;
    if (MK_N_LAUNCHES == 1) { a.ph_lo = 0; a.ph_hi = 8; hipLaunchKernelGGL(hymba_fwd, dim3(grid), dim3(NWAVES * 64), LDS_BYTES, stream, a); }
    else for (int li = 0; li < 8; ++li) { a.ph_lo = li; a.ph_hi = li + 1; hipLaunchKernelGGL(hymba_fwd, dim3(grid), dim3(NWAVES * 64), LDS_BYTES, stream, a); }
}
```

```cpp
#include <hip/hip_runtime.h>
#include <cstdio>
#include <cstdint>

#ifndef MK_N_LAUNCHES
#define MK_N_LAUNCHES 1
#endif

#define GAS __attribute__((address_space(1)))
#define LAS __attribute__((address_space(3)))
typedef unsigned short bf16;
typedef short bf16x8 __attribute__((ext_vector_type(8)));
typedef short s16x4 __attribute__((ext_vector_type(4)));
typedef float f32x2 __attribute__((ext_vector_type(2)));
typedef float f32x4 __attribute__((ext_vector_type(4)));
typedef float f32x16 __attribute__((ext_vector_type(16)));
typedef unsigned u32x2 __attribute__((ext_vector_type(2)));
typedef unsigned u32x4 __attribute__((ext_vector_type(4)));
typedef GAS unsigned gu32;
#define RLX_AGENT __ATOMIC_RELAXED, __HIP_MEMORY_SCOPE_AGENT
#define LDS_WAIT() asm volatile("s_waitcnt lgkmcnt(0)" ::: "memory")
#define VM_WAIT() asm volatile("s_waitcnt vmcnt(0)" ::: "memory")

constexpr int NTOK = 16384, DM = 1024, SEQ = 2048;
constexpr int IN_COLS = 2560, AW = 512;
constexpr int NEXP = 32, TOPK = 4, DFF = 1024, NPAIR = NTOK * TOPK;
constexpr int LISTCAP = NTOK;
constexpr int HIDROWS = NPAIR + NEXP * 256;
constexpr float LN_EPS = 1e-5f;
constexpr float ALPHA = 1.189207115002721f;
constexpr float LOG2E = 1.4426950408889634f;
constexpr float QSCALE = 0.125f * LOG2E;
constexpr float LAMBDA_INIT = 0.2f;
constexpr int NWAVES = 8;
constexpr float SX8 = 4.0f, SW8 = 64.0f, SH8 = 4.0f;

constexpr size_t MiB = 1u << 20;
constexpr size_t WS_CTL = 0, CTL_ZERO_BYTES = 1 * MiB;
constexpr size_t WS_WIN = 2 * MiB;
constexpr size_t WS_WOUT = 8 * MiB;
constexpr size_t WS_WGU = 16 * MiB;
constexpr size_t WS_WD = 144 * MiB;
constexpr size_t WS_XN = 208 * MiB;
constexpr size_t WS_Q = 240 * MiB, WS_K = 256 * MiB, WS_V = 272 * MiB, WS_HG = 288 * MiB;
constexpr size_t WS_AC = 304 * MiB;
constexpr size_t WS_Y1 = 336 * MiB;
constexpr size_t WS_X1 = 400 * MiB;
constexpr size_t WS_HID = 432 * MiB;
constexpr size_t WS_YP = 576 * MiB;
constexpr size_t WS_LIST = 704 * MiB;
constexpr size_t WS_GATE = 706 * MiB;
constexpr size_t WS_X1Q = 708 * MiB;
constexpr size_t WS_END = 724 * MiB;
constexpr int CW_TMO = 0;
constexpr int CW_BAR = 4096;
constexpr int CW_GCNT = 8192;

constexpr int RING_OFF = 0, RING_BYTES = 131072;
constexpr int LDSCTL_OFF = RING_BYTES, MISC_OFF = LDSCTL_OFF + 320;
constexpr int MOE_TP_OFF = LDSCTL_OFF + 1024;
constexpr int MOE_STG_OFF = LDSCTL_OFF + 2048;
constexpr int LDS_BYTES = 147456;

__device__ __forceinline__ unsigned cvt_pk_bf16(float lo, float hi) { unsigned r; asm volatile("v_cvt_pk_bf16_f32 %0, %1, %2" : "=v"(r) : "v"(lo), "v"(hi)); return r; }
__device__ __forceinline__ unsigned pk4_fp8(float a, float b, float c, float d) { int w = 0; w = __builtin_amdgcn_cvt_pk_fp8_f32(a, b, w, false); w = __builtin_amdgcn_cvt_pk_fp8_f32(c, d, w, true); return (unsigned)w; }
__device__ __forceinline__ float bf_lo(unsigned w) { return __uint_as_float(w << 16); }
__device__ __forceinline__ float bf_hi(unsigned w) { return __uint_as_float(w & 0xffff0000u); }
__device__ __forceinline__ float fast_exp2(float x) { return __builtin_amdgcn_exp2f(x); }
__device__ __forceinline__ float fast_rcp(float x) { return __builtin_amdgcn_rcpf(x); }
__device__ __forceinline__ float sigmoidf_(float x) { return fast_rcp(1.0f + fast_exp2(-LOG2E * x)); }
__device__ __forceinline__ float wave_sum(float v) {
#pragma unroll
    for (int o = 1; o < 64; o <<= 1) v += __shfl_xor(v, o);
    return v;
}

__device__ __forceinline__ void glds4(const void* gsrc, unsigned lds_dst) { unsigned keep;
    asm volatile("s_mov_b32 %0, m0\n\ts_mov_b32 m0, %2\n\ts_nop 0\n\tglobal_load_lds_dword %1, off\n\ts_mov_b32 m0, %0" : "=&s"(keep) : "v"(gsrc), "s"(lds_dst) : "memory"); }

namespace pg8 {
constexpr int BM = 256, BK = 64, HALF = 128, HTB = HALF * BK * 2, STAGE_BYTES = 8 * HTB, NXCD = 8, WGM = 8, KD = 1024;
__host__ __device__ __forceinline__ int lds_byte(int r, int c) { const int st = (r >> 4) * 2 + (c >> 5), rr = r & 15, cc = c & 31, ob = rr * 64 + cc * 2; return st * 1024 + (ob ^ (((ob >> 9) & 1) << 5)); }
__host__ __device__ __forceinline__ void stage_rc(int b, int& R, int& C) { const int st = b / 1024, sb = b % 1024, swz = sb ^ (((sb >> 9) & 1) << 5); R = (st >> 1) * 16 + swz / 64; C = (st & 1) * 32 + (swz % 64) / 2; }
__host__ __device__ __forceinline__ int perm32(int rho) { const int n = rho >> 4, i = rho & 15; return 8 * (i >> 2) + 4 * n + (i & 3); }

struct Unit { int pm, pn, e, mtl, cnt; };

struct DenseOrder {
    int nM, nN, nwg, G, c; const char* Bt;
    __device__ __forceinline__ void init(int M, int N, int G_, int c_, const void* Bt_) { nM = M / BM; nN = N / BM; nwg = nM * nN; G = G_; c = c_; Bt = (const char*)Bt_; }
    __device__ __forceinline__ bool next(int i, Unit& u) const {
        const long L = (long)i * G + c; if (L >= nwg) return false;
        int wgid = (int)L; { const int q = nwg / NXCD, r = nwg % NXCD, xcd = wgid % NXCD, off = wgid / NXCD; wgid = (xcd < r ? xcd * (q + 1) : r * (q + 1) + (xcd - r) * q) + off; }
        const int nig = WGM * nN, gid = wgid / nig, fm = gid * WGM, gsz = (nM - fm) < WGM ? (nM - fm) : WGM;
        u.pm = fm + ((wgid % nig) % gsz); u.pn = (wgid % nig) / gsz; u.e = 0; u.mtl = 0; u.cnt = 0; return true;
    }
    static constexpr bool STAGED = false;
    __device__ __forceinline__ unsigned arow_off(const Unit& u, int rl) const { return (unsigned)(u.pm * BM + rl) * (unsigned)(KD * 2); }
    __device__ __forceinline__ unsigned arow_off_staged(const Unit& u, int, int rl) const { return arow_off(u, rl); }
    __device__ __forceinline__ void stage(const Unit&, int, int, int) const {}
    __device__ __forceinline__ const LAS unsigned char* aux(int) const { return nullptr; }
    __device__ __forceinline__ const char* bbase(const Unit& u) const { return Bt + (size_t)u.pn * (size_t)(BM * KD * 2); }
};
template <int NPN, bool GATHER, int ROWB> struct MoeOrder {
    static constexpr bool STAGED = true;
    const LAS int* tp; const LAS int* cn; int G, vcu, lane; const int* list; const char* Bt; size_t bstride;
    const float* gatel; const float* bias; unsigned stg;
    __device__ __forceinline__ bool next(int i, Unit& u) const {
        const int L = i * G + vcu, chunk = L >> 5, s = L & 31;
        const int mt = (NPN == 8) ? chunk * 4 + (s & 3) : chunk * 8 + (s & 7), pn = (NPN == 8) ? (s >> 2) : (s >> 3);
        const int MT = tp[32];
        if (mt >= MT) return false;
        const int lj = lane < 1 ? 1 : (lane > 32 ? 32 : lane);
        const unsigned long long bm = __ballot(lane >= 1 && lane <= 32 && tp[lj] <= mt);
        const int e = __builtin_amdgcn_readfirstlane(__popcll(bm));
        u.pm = mt; u.pn = pn; u.e = e; u.mtl = __builtin_amdgcn_readfirstlane(mt - tp[e]); u.cnt = __builtin_amdgcn_readfirstlane(cn[e]); return true;
    }
    __device__ __forceinline__ void stage(const Unit& u, int slot, int wid, int ln) const {
        const unsigned d = (unsigned)__builtin_amdgcn_readfirstlane(stg + slot * 3072);
        const size_t lo = (size_t)u.e * LISTCAP + (size_t)u.mtl * BM + ln;
        if (wid == 0) { _Pragma("unroll") for (int k = 0; k < 4; ++k) glds4(list + lo + k * 64, d + k * 256); }
        else if (wid == 1) { _Pragma("unroll") for (int k = 0; k < 4; ++k) glds4(gatel + lo + k * 64, d + 1024 + k * 256); }
        else if (wid == 2) {
            if (NPN == 8) { const float* bg = bias + (size_t)u.e * 2048 + u.pn * 128 + ln;
                _Pragma("unroll") for (int k = 0; k < 2; ++k) { glds4(bg + k * 64, d + 2048 + k * 256); glds4(bg + 1024 + k * 64, d + 2560 + k * 256); } }
            else { const float* bd = bias + (size_t)u.e * 1024 + u.pn * 256 + ln;
                _Pragma("unroll") for (int k = 0; k < 4; ++k) glds4(bd + k * 64, d + 2048 + k * 256); }
        }
    }
    __device__ __forceinline__ const LAS unsigned char* aux(int slot) const { return (const LAS unsigned char*)(size_t)(stg + slot * 3072); }
    __device__ __forceinline__ unsigned arow_off(const Unit& u, int rl) const {
        if (GATHER) { int pos = u.mtl * BM + rl; pos = pos < u.cnt ? pos : u.cnt - 1; const int p = list[u.e * LISTCAP + pos]; return (unsigned)(p >> 2) * (unsigned)ROWB; }
        else return (unsigned)(u.pm * BM + rl) * (unsigned)ROWB;
    }
    __device__ __forceinline__ unsigned arow_off_staged(const Unit& u, int slot, int rl) const {
        if (GATHER) { const int nv = u.cnt - u.mtl * BM; const int r = rl < nv ? rl : nv - 1; const int p = ((const LAS int*)aux(slot))[r]; return (unsigned)(p >> 2) * (unsigned)ROWB; }
        else return (unsigned)(u.pm * BM + rl) * (unsigned)ROWB;
    }
    __device__ __forceinline__ const char* bbase(const Unit& u) const { return Bt + (size_t)u.e * bstride + (size_t)u.pn * (size_t)(BM * ROWB); }
};

typedef int i32x4 __attribute__((ext_vector_type(4)));
typedef int i32x8 __attribute__((ext_vector_type(8)));
template <class Epi, class Sched, bool FP8 = false>
__device__ __forceinline__ void gemm_phase(LAS unsigned char* lds, const char* Abase, const Sched& S, const Epi& E) {
    const int tid = threadIdx.x, wid = __builtin_amdgcn_readfirstlane(tid >> 6), lane = tid & 63, wr = wid >> 2, wc = wid & 3, fr = lane & 15, fq = lane >> 4;
    constexpr int ROWB = FP8 ? KD : KD * 2, nt = ROWB / (BK * 2);
    int RA[2]; unsigned CA2[2], voffB[2];
#pragma unroll
    for (int i = 0; i < 2; ++i) { int R, C; stage_rc(tid * 16 + i * 8192, R, C); const int Rb = Epi::PERM ? ((R & ~31) + perm32(R & 31)) : R;
        RA[i] = R; CA2[i] = (unsigned)C * 2u; voffB[i] = (unsigned)(Rb * ROWB + C * 2); }
    constexpr size_t kstep = (size_t)(BK * 2);
    constexpr size_t hstep = (size_t)HALF * ROWB;
    const unsigned ldsw = (unsigned)wid * 1024u;
    const int aoff = lds_byte(wr * 64 + fr, fq * 8), boff = lds_byte(wc * 32 + fr, fq * 8);
#define PG8_SA(b, h) (((b) * 2 + (h)) * HTB)
#define PG8_SB(b, h) ((4 + (b) * 2 + (h)) * HTB)
#define PG8_STAGE_B(bufoff, gbase) do { _Pragma("unroll") for (int _i = 0; _i < 2; ++_i) \
        __builtin_amdgcn_global_load_lds((const unsigned*)((const char*)(gbase) + voffB[_i]), (LAS unsigned*)(lds + (bufoff) + ldsw + _i * 8192), 16, 0, 0); } while (0)
#define PG8_STAGE_A(bufoff, offs, kb) do { _Pragma("unroll") for (int _i = 0; _i < 2; ++_i) \
        __builtin_amdgcn_global_load_lds((const unsigned*)(Abase + (size_t)(offs)[_i] + (size_t)(kb)), (LAS unsigned*)(lds + (bufoff) + ldsw + _i * 8192), 16, 0, 0); } while (0)
#define PG8_LD8(p) __builtin_shufflevector(*(const LAS i32x4*)(p), *(const LAS i32x4*)((p) + 1024), 0, 1, 2, 3, 4, 5, 6, 7)
#define PG8_LDA(dst, b, h) do { _Pragma("unroll") for (int m = 0; m < 4; ++m) { if constexpr (FP8) dst##8[m] = PG8_LD8(lds + PG8_SA(b, h) + aoff + m * 2048); else { _Pragma("unroll") for (int k = 0; k < 2; ++k) dst[m][k] = *(const LAS bf16x8*)(lds + PG8_SA(b, h) + aoff + m * 2048 + k * 1024); } } } while (0)
#define PG8_LDB(dst, b, h) do { _Pragma("unroll") for (int n = 0; n < 2; ++n) { if constexpr (FP8) dst##8[n] = PG8_LD8(lds + PG8_SB(b, h) + boff + n * 2048); else { _Pragma("unroll") for (int k = 0; k < 2; ++k) dst[n][k] = *(const LAS bf16x8*)(lds + PG8_SB(b, h) + boff + n * 2048 + k * 1024); } } } while (0)
#define PG8_MMA(ai, bj, At, Bt) do { __builtin_amdgcn_s_setprio(1); _Pragma("unroll") for (int m = 0; m < 4; ++m) _Pragma("unroll") for (int n = 0; n < 2; ++n) { \
        if constexpr (FP8) asm volatile("s_nop 1\n\tv_mfma_f32_16x16x128_f8f6f4 %0, %1, %2, %0" : "+v"(acc[ai][bj][m][n]) : "v"(Bt##8[n]), "v"(At##8[m])); \
        else { _Pragma("unroll") for (int k = 0; k < 2; ++k) acc[ai][bj][m][n] = __builtin_amdgcn_mfma_f32_16x16x32_bf16(Bt[n][k], At[m][k], acc[ai][bj][m][n], 0, 0, 0); } } \
        __builtin_amdgcn_s_setprio(0); } while (0)
#define PG8_WAIT_V(n) asm volatile("s_waitcnt vmcnt(" #n ")" ::: "memory")
#define PG8_WAIT_L(n) asm volatile("s_waitcnt lgkmcnt(" #n ")" ::: "memory")
#define PG8_BAR __builtin_amdgcn_s_barrier()
#define PG8_SCHED __builtin_amdgcn_sched_barrier(0)
    Unit cur, nxt; int ui = 0;
    if (!S.next(0, cur)) return;
    f32x4 acc[2][2][4][2];
#pragma unroll
    for (int a = 0; a < 2; ++a)
#pragma unroll
        for (int b = 0; b < 2; ++b)
#pragma unroll
            for (int m = 0; m < 4; ++m)
#pragma unroll
                for (int n = 0; n < 2; ++n) { acc[a][b][m][n] = (f32x4){0.f, 0.f, 0.f, 0.f}; asm volatile("" : "+v"(acc[a][b][m][n])); }
    bf16x8 At[4][2], B0[2][2], B1[2][2];
    i32x8 At8[4], B08[2], B18[2];
    unsigned ao[2][2], no[2][2];
    if constexpr (Sched::STAGED) { S.stage(cur, 0, wid, lane); asm volatile("s_waitcnt vmcnt(0)" ::: "memory"); __syncthreads(); }
#pragma unroll
    for (int h = 0; h < 2; ++h)
#pragma unroll
        for (int i = 0; i < 2; ++i) ao[h][i] = S.arow_off_staged(cur, 0, h * HALF + RA[i]) + CA2[i];
    const char* cB = S.bbase(cur);
    PG8_STAGE_B(PG8_SB(0, 0), cB); PG8_STAGE_B(PG8_SB(0, 1), cB + hstep); PG8_STAGE_A(PG8_SA(0, 0), ao[0], 0); PG8_STAGE_A(PG8_SA(0, 1), ao[1], 0);
    if (wr == 1) PG8_BAR;
    PG8_WAIT_V(2); PG8_BAR;
    PG8_STAGE_B(PG8_SB(1, 0), cB + kstep); PG8_STAGE_A(PG8_SA(1, 0), ao[0], kstep); PG8_STAGE_B(PG8_SB(1, 1), cB + hstep + kstep);
    PG8_WAIT_V(6); PG8_BAR;
    for (;;) {
        const bool has_next = S.next(ui + 1, nxt);
        const char* nB = cB;
        if (has_next) {
            if constexpr (Sched::STAGED) S.stage(nxt, (ui + 1) % 3, wid, lane);
            else {
#pragma unroll
            for (int h = 0; h < 2; ++h)
#pragma unroll
                for (int i = 0; i < 2; ++i) no[h][i] = S.arow_off(nxt, h * HALF + RA[i]) + CA2[i];
            }
            nB = S.bbase(nxt);
        } else {
#pragma unroll
            for (int h = 0; h < 2; ++h)
#pragma unroll
                for (int i = 0; i < 2; ++i) no[h][i] = ao[h][i];
        }
#pragma nounroll
        for (int t = 0; t < nt; t += 2) {
            const bool last = (t == nt - 2);
            const size_t kb1 = (size_t)(t + 1) * kstep;
            unsigned s2[2][2];
            if constexpr (Sched::STAGED) { if (last && has_next) {
#pragma unroll
                for (int h = 0; h < 2; ++h)
#pragma unroll
                    for (int i = 0; i < 2; ++i) no[h][i] = S.arow_off_staged(nxt, (ui + 1) % 3, h * HALF + RA[i]) + CA2[i]; } }
#pragma unroll
            for (int h = 0; h < 2; ++h)
#pragma unroll
                for (int i = 0; i < 2; ++i) s2[h][i] = last ? no[h][i] : ao[h][i];
            const size_t kb2 = last ? 0 : (size_t)(t + 2) * kstep, kb3 = kb2 + kstep;
            const char* b2 = last ? nB : cB + (size_t)(t + 2) * kstep; const char* b3 = b2 + kstep;
            PG8_LDB(B0, 0, 0); PG8_LDB(B1, 0, 1); PG8_SCHED; PG8_LDA(At, 0, 0); PG8_STAGE_A(PG8_SA(1, 1), ao[1], kb1);
            PG8_WAIT_V(8); PG8_WAIT_L(0); PG8_BAR; PG8_MMA(0, 0, At, B0); PG8_MMA(0, 1, At, B1); PG8_BAR; PG8_SCHED;
            PG8_LDA(At, 0, 1); PG8_STAGE_B(PG8_SB(0, 0), b2); PG8_STAGE_B(PG8_SB(0, 1), b2 + hstep); PG8_STAGE_A(PG8_SA(0, 0), s2[0], kb2);
            PG8_WAIT_V(8); PG8_WAIT_L(0); PG8_BAR; PG8_MMA(1, 0, At, B0); PG8_MMA(1, 1, At, B1); PG8_BAR; PG8_SCHED;
            PG8_LDB(B0, 1, 0); PG8_LDB(B1, 1, 1); PG8_SCHED; PG8_LDA(At, 1, 0); PG8_STAGE_A(PG8_SA(0, 1), s2[1], kb2);
            PG8_WAIT_V(8); PG8_WAIT_L(0); PG8_BAR; PG8_MMA(0, 0, At, B0); PG8_MMA(0, 1, At, B1); PG8_BAR; PG8_SCHED;
            PG8_LDA(At, 1, 1); PG8_STAGE_B(PG8_SB(1, 0), b3); PG8_STAGE_B(PG8_SB(1, 1), b3 + hstep); PG8_STAGE_A(PG8_SA(1, 0), s2[0], kb3);
            PG8_WAIT_V(8); PG8_WAIT_L(0); PG8_BAR; PG8_MMA(1, 0, At, B0); PG8_MMA(1, 1, At, B1); PG8_BAR; PG8_SCHED;
        }
        if (wr == 0) PG8_BAR;
        if constexpr (FP8) asm volatile("s_nop 15\n\ts_nop 7" ::: "memory");
        E(acc, cur, wr, wc, fr, fq, S.aux(ui % 3));
        if (!has_next) break;
#pragma unroll
        for (int a = 0; a < 2; ++a)
#pragma unroll
            for (int b = 0; b < 2; ++b)
#pragma unroll
                for (int m = 0; m < 4; ++m)
#pragma unroll
                    for (int n = 0; n < 2; ++n) { acc[a][b][m][n] = (f32x4){0.f, 0.f, 0.f, 0.f}; asm volatile("" : "+v"(acc[a][b][m][n])); }
        cur = nxt; cB = nB; ++ui;
#pragma unroll
        for (int h = 0; h < 2; ++h)
#pragma unroll
            for (int i = 0; i < 2; ++i) ao[h][i] = no[h][i];
        if (wr == 1) PG8_BAR;
    }
    PG8_WAIT_V(0);
    PG8_BAR;
#undef PG8_SA
#undef PG8_SB
#undef PG8_STAGE_A
#undef PG8_STAGE_B
#undef PG8_LDA
#undef PG8_LDB
#undef PG8_MMA
#undef PG8_LD8
#undef PG8_WAIT_V
#undef PG8_WAIT_L
#undef PG8_BAR
#undef PG8_SCHED
}

struct EpiIn {
    static constexpr bool PERM = true;
    bf16* Q; size_t qkv_stride;
    __device__ __forceinline__ void operator()(const f32x4 (&acc)[2][2][4][2], const Unit& u, int wr, int wc, int fr, int fq, const LAS unsigned char* aux) const {
        const int row0 = u.pm * BM + wr * 64 + fr; bf16* HG = Q + 3 * qkv_stride;
        if (u.pn < 6) {
            bf16* base = Q + (size_t)(u.pn >> 1) * qkv_stride; const float sc = u.pn < 2 ? QSCALE : 1.0f;
            const int col0 = (u.pn & 1) * 256 + wc * 32 + 8 * fq;
#pragma unroll
            for (int ai = 0; ai < 2; ++ai)
#pragma unroll
                for (int m = 0; m < 4; ++m) { bf16* rowp = base + (size_t)(row0 + ai * HALF + m * 16) * AW + col0;
#pragma unroll
                    for (int bj = 0; bj < 2; ++bj) { const f32x4 v0 = acc[ai][bj][m][0] * sc, v1 = acc[ai][bj][m][1] * sc;
                        u32x4 w; w.x = cvt_pk_bf16(v0[0], v0[1]); w.y = cvt_pk_bf16(v0[2], v0[3]); w.z = cvt_pk_bf16(v1[0], v1[1]); w.w = cvt_pk_bf16(v1[2], v1[3]);
                        *(u32x4*)(rowp + bj * HALF) = w; } }
        } else {
            const int col0 = (u.pn - 6) * 128 + wc * 32 + 8 * fq;
#pragma unroll
            for (int ai = 0; ai < 2; ++ai)
#pragma unroll
                for (int m = 0; m < 4; ++m) { bf16* rowp = HG + (size_t)(row0 + ai * HALF + m * 16) * AW + col0;
                    float o[8];
#pragma unroll
                    for (int n = 0; n < 2; ++n)
#pragma unroll
                        for (int j = 0; j < 4; ++j) o[n * 4 + j] = acc[ai][0][m][n][j] * sigmoidf_(acc[ai][1][m][n][j]);
                    u32x4 w; w.x = cvt_pk_bf16(o[0], o[1]); w.y = cvt_pk_bf16(o[2], o[3]); w.z = cvt_pk_bf16(o[4], o[5]); w.w = cvt_pk_bf16(o[6], o[7]);
                    *(u32x4*)rowp = w; }
        }
    }
};
struct EpiOut {
    static constexpr bool PERM = false;
    float* Y1; const bf16* XN;
    __device__ __forceinline__ void operator()(const f32x4 (&acc)[2][2][4][2], const Unit& u, int wr, int wc, int fr, int fq, const LAS unsigned char* aux) const {
        const int row0 = u.pm * BM + wr * 64 + fr, col0 = u.pn * BM + wc * 32 + 4 * fq;
#pragma unroll
        for (int ai = 0; ai < 2; ++ai)
#pragma unroll
            for (int m = 0; m < 4; ++m) { const size_t ro = (size_t)(row0 + ai * HALF + m * 16) * DM + col0;
#pragma unroll
                for (int bj = 0; bj < 2; ++bj)
#pragma unroll
                    for (int n = 0; n < 2; ++n) { const u32x2 xw = *(const u32x2*)(XN + ro + bj * HALF + n * 16);
                        f32x4 o = acc[ai][bj][m][n]; o[0] += ALPHA * bf_lo(xw.x); o[1] += ALPHA * bf_hi(xw.x); o[2] += ALPHA * bf_lo(xw.y); o[3] += ALPHA * bf_hi(xw.y);
                        *(f32x4*)(Y1 + ro + bj * HALF + n * 16) = o; } }
    }
};
struct EpiSwiglu {
    static constexpr bool PERM = true;
    unsigned char* HID; const float* bgu;
    __device__ __forceinline__ void operator()(const f32x4 (&acc)[2][2][4][2], const Unit& u, int wr, int wc, int fr, int fq, const LAS unsigned char* aux) const {
        const int row0 = u.pm * BM + wr * 64 + fr, ch0 = u.pn * 128 + wc * 32 + 8 * fq; constexpr float ISC = 1.0f / (SX8 * SW8);
        const LAS float* bg = (const LAS float*)(aux + 2048) + wc * 32 + 8 * fq; const LAS float* bu = bg + 128;
        f32x4 bgv[2], buv[2];
#pragma unroll
        for (int n = 0; n < 2; ++n) { bgv[n] = *(const LAS f32x4*)(bg + 4 * n); buv[n] = *(const LAS f32x4*)(bu + 4 * n); }
#pragma unroll
        for (int ai = 0; ai < 2; ++ai)
#pragma unroll
            for (int m = 0; m < 4; ++m) { unsigned char* rowp = HID + (size_t)(row0 + ai * HALF + m * 16) * DFF + ch0;
                float o[8];
#pragma unroll
                for (int n = 0; n < 2; ++n)
#pragma unroll
                    for (int j = 0; j < 4; ++j) { float g = acc[ai][0][m][n][j] * ISC + bgv[n][j], up = acc[ai][1][m][n][j] * ISC + buv[n][j];
                        g = fminf(g, 7.0f); up = fminf(fmaxf(up, -7.0f), 7.0f);
                        o[n * 4 + j] = g * sigmoidf_(1.702f * g) * (up + 1.0f) * SH8; }
                u32x2 w; w.x = pk4_fp8(o[0], o[1], o[2], o[3]); w.y = pk4_fp8(o[4], o[5], o[6], o[7]);
                *(u32x2*)rowp = w; }
    }
};
struct EpiDown {
    static constexpr bool PERM = true;
    bf16* YP; const float* bd; const int* list; const float* gatew;
    __device__ __forceinline__ void operator()(const f32x4 (&acc)[2][2][4][2], const Unit& u, int wr, int wc, int fr, int fq, const LAS unsigned char* aux) const {
        const int rl0 = wr * 64 + fr, col0 = u.pn * BM + wc * 32 + 8 * fq;
        f32x4 bv[2][2];
#pragma unroll
        for (int bj = 0; bj < 2; ++bj)
#pragma unroll
            for (int n = 0; n < 2; ++n) bv[bj][n] = *(const LAS f32x4*)((const LAS float*)(aux + 2048) + wc * 32 + 8 * fq + bj * HALF + 4 * n);
#pragma unroll
        for (int ai = 0; ai < 2; ++ai)
#pragma unroll
            for (int m = 0; m < 4; ++m) { const int pos = u.mtl * BM + rl0 + ai * HALF + m * 16;
                if (pos < u.cnt) { const int rl = rl0 + ai * HALF + m * 16; const int p = ((const LAS int*)aux)[rl]; const float gw = ((const LAS float*)(aux + 1024))[rl]; bf16* rowp = YP + (size_t)p * DM + col0;
#pragma unroll
                    for (int bj = 0; bj < 2; ++bj) { constexpr float ISC = 1.0f / (SH8 * SW8); const f32x4 v0 = (acc[ai][bj][m][0] * ISC + bv[bj][0]) * gw, v1 = (acc[ai][bj][m][1] * ISC + bv[bj][1]) * gw;
                        u32x4 w; w.x = cvt_pk_bf16(v0[0], v0[1]); w.y = cvt_pk_bf16(v0[2], v0[3]); w.z = cvt_pk_bf16(v1[0], v1[1]); w.w = cvt_pk_bf16(v1[2], v1[3]);
                        *(u32x4*)(rowp + bj * HALF) = w; } } }
    }
};
}

#define XB_TMO      128
#define XB_XCNT(j)  (256  + 64 * (j))
#define XB_XSUB(j)  (1280 + 64 * (j))
#define XB_XGEN(j)  (2304 + 64 * (j))
#define XB_TOP      3328
#define XB_TOPGEN   3392
#define XCD_BAR_WORDS 3456
#define XB_SPIN_CAP (1u << 18)
__device__ __forceinline__ unsigned xb_ld(unsigned* p)              { return __hip_atomic_load(p, __ATOMIC_RELAXED, __HIP_MEMORY_SCOPE_AGENT); }
__device__ __forceinline__ unsigned xb_add(unsigned* p, unsigned v) { return __hip_atomic_fetch_add(p, v, __ATOMIC_RELAXED, __HIP_MEMORY_SCOPE_AGENT); }
__device__ __forceinline__ unsigned xb_xcc_id() { return (unsigned)__builtin_amdgcn_s_getreg((3 << 11) | 20) & 0xFu; }
#define XB_SPIN(cond, bar) do { unsigned _sp = 0; while (cond) { __builtin_amdgcn_s_sleep(1); \
    if ((++_sp & 255u) == 0u) { if (xb_ld(&(bar)[XB_TMO])) break; if (_sp > XB_SPIN_CAP) { atomicAdd(&(bar)[XB_TMO], 1u); break; } } } } while (0)
struct XcdBarrier { unsigned* bar; unsigned x; volatile LAS unsigned* st; };
__device__ __forceinline__ XcdBarrier xcd_barrier_post(unsigned* bar, volatile LAS unsigned* st) {
    XcdBarrier b; b.bar = bar; b.x = xb_xcc_id(); b.st = st;
    if (threadIdx.x == 0) (void)xb_add(&bar[XB_XCNT(b.x)], 1u);
    return b;
}
__device__ __forceinline__ void xcd_barrier_complete(unsigned* bar, unsigned x, unsigned& nloc, unsigned& nx) {
    const unsigned G = gridDim.x * gridDim.y * gridDim.z;
    unsigned sum, cnt, mine, sp = 0u;
    for (;;) {
        sum = 0u; cnt = 0u; mine = 0u;
#pragma unroll
        for (unsigned j = 0; j < 16; ++j) { const unsigned c = xb_ld(&bar[XB_XCNT(j)]); sum += c; cnt += (c > 0u) ? 1u : 0u; mine = (j == x) ? c : mine; }
        if (sum == G) break;
        __builtin_amdgcn_s_sleep(1);
        if ((++sp & 255u) == 0u) { if (xb_ld(&bar[XB_TMO])) break; if (sp > XB_SPIN_CAP) { atomicAdd(&bar[XB_TMO], 1u); break; } }
    }
    nloc = mine > 0u ? mine : 1u; nx = cnt > 0u ? cnt : 1u;
}
__device__ __forceinline__ void xcd_barrier(const XcdBarrier& b) {
    asm volatile("s_waitcnt vmcnt(0)" ::: "memory");
    __syncthreads();
    if (threadIdx.x == 0) {
        unsigned* bar = b.bar;
        __builtin_amdgcn_s_waitcnt(0);
        unsigned nloc = b.st[0], nx = b.st[1];
        if (nloc == 0u) { xcd_barrier_complete(bar, b.x, nloc, nx); b.st[0] = nloc; b.st[1] = nx; }
        const unsigned old = xb_add(&bar[XB_XSUB(b.x)], 1u);
        const unsigned gen = old / nloc;
        if (old + 1u == (gen + 1u) * nloc) {
            __builtin_amdgcn_fence(__ATOMIC_RELEASE, "agent");
            asm volatile("s_waitcnt vmcnt(0)" ::: "memory");
            const unsigned og = xb_add(&bar[XB_TOP], 1u);
            const unsigned tg = og / nx;
            if (og + 1u == (tg + 1u) * nx) xb_add(&bar[XB_TOPGEN], 1u);
            else XB_SPIN(xb_ld(&bar[XB_TOPGEN]) == tg, bar);
            __builtin_amdgcn_fence(__ATOMIC_ACQUIRE, "agent");
            xb_add(&bar[XB_XGEN(b.x)], 1u);
            asm volatile("s_waitcnt vmcnt(0)" ::: "memory");
        } else {
            XB_SPIN(xb_ld(&bar[XB_XGEN(b.x)]) == gen, bar);
            __builtin_amdgcn_fence(__ATOMIC_ACQUIRE, "agent");
            asm volatile("s_waitcnt vmcnt(0)" ::: "memory");
        }
    }
    __syncthreads();
}

struct Frame {
    LAS unsigned char* lds; volatile LAS unsigned* MISC; gu32* ctl;
    int tid, lane, wave, vcu, G;
};
struct Args { const float* in[24]; float* out; unsigned char* ws; int ph_lo, ph_hi; };

__device__ __forceinline__ void p0_transpose_item(const float* W, int K, int N, bf16* WT, int k0, int n0, int drow0, LAS float* scr, int lane) {
#pragma unroll 8
    for (int i = 0; i < 32; ++i) { const int kk = 2 * i + (lane >> 5); scr[kk * 33 + (lane & 31)] = W[(size_t)(k0 + kk) * N + n0 + (lane & 31)]; }
    LDS_WAIT(); asm volatile("" ::: "memory");
    const int c = lane & 7;
#pragma unroll
    for (int j = 0; j < 4; ++j) { const int n = (lane >> 3) + 8 * j; const LAS float* s = scr + (8 * c) * 33 + n;
        u32x4 o; o.x = cvt_pk_bf16(s[0 * 33], s[1 * 33]); o.y = cvt_pk_bf16(s[2 * 33], s[3 * 33]); o.z = cvt_pk_bf16(s[4 * 33], s[5 * 33]); o.w = cvt_pk_bf16(s[6 * 33], s[7 * 33]);
        *(GAS u32x4*)(WT + (size_t)(drow0 + n) * K + k0 + 8 * c) = o; }
    LDS_WAIT(); asm volatile("" ::: "memory");
}
__device__ __forceinline__ void p0_transpose_item_fp8(const float* W, int K, int N, unsigned char* WT8, int k0, int n0, int drow0, LAS float* scr, int lane, float scale) {
#pragma unroll 8
    for (int i = 0; i < 32; ++i) { const int kk = 2 * i + (lane >> 5); scr[kk * 33 + (lane & 31)] = W[(size_t)(k0 + kk) * N + n0 + (lane & 31)]; }
    LDS_WAIT(); asm volatile("" ::: "memory");
    const int c = lane & 7;
#pragma unroll
    for (int j = 0; j < 4; ++j) { const int n = (lane >> 3) + 8 * j; const LAS float* s = scr + (8 * c) * 33 + n;
        u32x2 o; o.x = pk4_fp8(s[0 * 33] * scale, s[1 * 33] * scale, s[2 * 33] * scale, s[3 * 33] * scale); o.y = pk4_fp8(s[4 * 33] * scale, s[5 * 33] * scale, s[6 * 33] * scale, s[7 * 33] * scale);
        *(GAS u32x2*)(WT8 + (size_t)(drow0 + n) * K + k0 + 8 * c) = o; }
    LDS_WAIT(); asm volatile("" ::: "memory");
}
__device__ __forceinline__ void ln_row_to_bf16(const float* xrow, const float* g, const float* b, bf16* orow, int lane) {
    const GAS f32x4* xr = (const GAS f32x4*)xrow + lane;
    f32x4 v[4]; float s = 0.f;
#pragma unroll
    for (int j = 0; j < 4; ++j) { v[j] = xr[64 * j]; s += (v[j].x + v[j].y) + (v[j].z + v[j].w); }
    const float mean = wave_sum(s) * (1.f / DM); float s2 = 0.f;
#pragma unroll
    for (int j = 0; j < 4; ++j) { v[j] = v[j] - mean; s2 += (v[j].x * v[j].x + v[j].y * v[j].y) + (v[j].z * v[j].z + v[j].w * v[j].w); }
    const float rstd = 1.f / sqrtf(wave_sum(s2) * (1.f / DM) + LN_EPS);
    GAS u32x2* o8 = (GAS u32x2*)orow + lane;
#pragma unroll
    for (int j = 0; j < 4; ++j) { const f32x4 gg = *((const GAS f32x4*)g + lane + 64 * j), bb = *((const GAS f32x4*)b + lane + 64 * j);
        const f32x4 y = v[j] * rstd * gg + bb; u32x2 w; w.x = cvt_pk_bf16(y.x, y.y); w.y = cvt_pk_bf16(y.z, y.w); o8[64 * j] = w; }
}

namespace att {
constexpr int STG = 32768;
constexpr int LDS_WS = LDSCTL_OFF + 2048;
__device__ __forceinline__ void glds16(const void* gsrc, unsigned lds_dst) { unsigned keep;
    asm volatile("s_mov_b32 %0, m0\n\ts_mov_b32 m0, %2\n\ts_nop 0\n\tglobal_load_lds_dwordx4 %1, off\n\ts_mov_b32 m0, %0" : "=&s"(keep) : "v"(gsrc), "s"(lds_dst) : "memory"); }
__device__ __forceinline__ int crow(int r, int hi) { return (r & 3) + 8 * (r >> 2) + 4 * hi; }
__device__ __forceinline__ float swapmax(float m) { auto rr = __builtin_amdgcn_permlane32_swap(__float_as_uint(m), __float_as_uint(m), false, false); return fmaxf(__uint_as_float(rr[0]), __uint_as_float(rr[1])); }
__device__ __forceinline__ float swapsum(float m) { auto rr = __builtin_amdgcn_permlane32_swap(__float_as_uint(m), __float_as_uint(m), false, false); return __uint_as_float(rr[0]) + __uint_as_float(rr[1]); }
__device__ __forceinline__ s16x4 vtr(const LAS unsigned char* p) { typedef short v4i16_t __attribute__((ext_vector_type(4))); return __builtin_bit_cast(s16x4, __builtin_amdgcn_ds_read_tr16_b64_v4i16((LAS v4i16_t*)p)); }
}

__global__ void __launch_bounds__(NWAVES * 64, 2) hymba_fwd(Args args) {
    extern __shared__ __attribute__((aligned(16))) unsigned char lds_raw[];
    Frame F;
    F.lds = (LAS unsigned char*)lds_raw;
    F.MISC = (volatile LAS unsigned*)(F.lds + MISC_OFF);
    F.tid = threadIdx.x; F.lane = F.tid & 63; F.wave = __builtin_amdgcn_readfirstlane(F.tid >> 6);
    F.G = gridDim.x; { const int bx = blockIdx.x; F.vcu = (F.G % 8 == 0) ? (bx % 8) * (F.G / 8) + bx / 8 : bx; }
    unsigned char* ws = args.ws;
    F.ctl = (gu32*)(ws + WS_CTL);
    for (int u = F.tid; u < (LDS_BYTES - LDSCTL_OFF) / 4; u += NWAVES * 64) ((LAS unsigned*)(F.lds + LDSCTL_OFF))[u] = 0u;
    __syncthreads();
    XcdBarrier bar; bar.bar = (unsigned*)(F.ctl + CW_BAR); bar.x = 0; bar.st = nullptr;
    if (MK_N_LAUNCHES == 1) bar = xcd_barrier_post((unsigned*)(F.ctl + CW_BAR), F.MISC + 8);
    const int lo = args.ph_lo, hi = args.ph_hi;
#ifndef PH_MASK
#define PH_MASK 0xff
#endif
#define IN(k) (((PH_MASK >> (k)) & 1) && lo <= (k) && (k) < hi)
#define BOTH(k) (IN(k) && IN((k) + 1))
#ifndef REP_MASK
#define REP_MASK 0
#endif
#define NREP(k) (((REP_MASK >> (k)) & 1) ? 2 : 1)
#define GRID_BAR() do { xcd_barrier(bar); } while (0)
    const int lane = F.lane, wave = F.wave, tid = F.tid;
    const int gw = F.vcu * NWAVES + wave, NGW = F.G * NWAVES;

    const float* x_in = args.in[0];
    bf16* Win_t = (bf16*)(ws + WS_WIN); bf16* Wout_t = (bf16*)(ws + WS_WOUT); unsigned char* Wgu_t = ws + WS_WGU; unsigned char* Wd_t = ws + WS_WD;
    bf16* XN = (bf16*)(ws + WS_XN); bf16* Qb = (bf16*)(ws + WS_Q); bf16* Kb = (bf16*)(ws + WS_K); bf16* Vb = (bf16*)(ws + WS_V); bf16* HG = (bf16*)(ws + WS_HG);
    bf16* AC = (bf16*)(ws + WS_AC); float* Y1 = (float*)(ws + WS_Y1); bf16* X1 = (bf16*)(ws + WS_X1); unsigned char* HID = ws + WS_HID; bf16* YP = (bf16*)(ws + WS_YP); unsigned char* X1Q = ws + WS_X1Q;
    int* LIST = (int*)(ws + WS_LIST); float* GATEW = (float*)(ws + WS_GATE);

    if (IN(0)) {
      for (int rep_ = 0; rep_ < NREP(0); ++rep_) {
        LAS float* scr = (LAS float*)(F.lds + RING_OFF + wave * 16384);
        constexpr int I_IN = 16 * (IN_COLS / 32), I_OUT = 16 * 32, I_GU = 16 * 64, I_D = 16 * 32;
        constexpr int NITEMS = I_IN + I_OUT + NEXP * I_GU + NEXP * I_D;
        struct TItem { const float* W; unsigned char* dst; int N, k0, n0, drow0, fp8; };
        auto decode = [&](int it) -> TItem {
            TItem ti; int r = it;
            if (r < I_IN) { const int nblk = IN_COLS / 32, kb = r / nblk, nb = r % nblk, n0 = 32 * nb; int d;
                if (n0 < 1536) d = n0; else { const int j = n0 - 1536, g = j >= 512, ch = j & 511; d = 1536 + (ch >> 7) * 256 + g * 128 + (ch & 127); }
                ti.W = args.in[3]; ti.dst = (unsigned char*)Win_t; ti.N = IN_COLS; ti.k0 = 64 * kb; ti.n0 = n0; ti.drow0 = d; ti.fp8 = 0; return ti; }
            r -= I_IN;
            if (r < I_OUT) { const int kb = r / 32, nb = r % 32; ti.W = args.in[13]; ti.dst = (unsigned char*)Wout_t; ti.N = DM; ti.k0 = 64 * kb; ti.n0 = 32 * nb; ti.drow0 = 32 * nb; ti.fp8 = 0; return ti; }
            r -= I_OUT;
            if (r < NEXP * I_GU) { const int e = r / I_GU, q = r % I_GU, kb = q / 64, nb = q % 64, n0 = 32 * nb, g = n0 >= 1024, ch = n0 & 1023, d = (ch >> 7) * 256 + g * 128 + (ch & 127);
                ti.W = args.in[18] + (size_t)e * DM * 2048; ti.dst = Wgu_t + (size_t)e * 2048 * DM; ti.N = 2048; ti.k0 = 64 * kb; ti.n0 = n0; ti.drow0 = d; ti.fp8 = 1; return ti; }
            r -= NEXP * I_GU;
            { const int e = r / I_D, q = r % I_D, kb = q / 32, nb = q % 32;
                ti.W = args.in[20] + (size_t)e * DFF * DM; ti.dst = Wd_t + (size_t)e * DM * DFF; ti.N = DM; ti.k0 = 64 * kb; ti.n0 = 32 * nb; ti.drow0 = 32 * nb; ti.fp8 = 1; return ti; }
        };
        const int kr = lane >> 3, c4 = lane & 7;
        f32x4 tv[8], tn[8];
        TItem cur_i, nxt_i;
        int it = gw;
        if (it < NITEMS) { cur_i = decode(it);
#pragma unroll
            for (int i = 0; i < 8; ++i) tv[i] = __builtin_nontemporal_load((const GAS f32x4*)(cur_i.W + (size_t)(cur_i.k0 + kr + 8 * i) * cur_i.N + cur_i.n0 + 4 * c4)); }
        for (; it < NITEMS; it += NGW) {
            const bool has_n = it + NGW < NITEMS;
            if (has_n) { nxt_i = decode(it + NGW);
#pragma unroll
                for (int i = 0; i < 8; ++i) tn[i] = __builtin_nontemporal_load((const GAS f32x4*)(nxt_i.W + (size_t)(nxt_i.k0 + kr + 8 * i) * nxt_i.N + nxt_i.n0 + 4 * c4)); }
#pragma unroll
            for (int i = 0; i < 8; ++i) { LAS float* sp = scr + (kr + 8 * i) * 33 + 4 * c4; sp[0] = tv[i][0]; sp[1] = tv[i][1]; sp[2] = tv[i][2]; sp[3] = tv[i][3]; }
            LDS_WAIT(); asm volatile("" ::: "memory");
            { const int c = lane & 7;
#pragma unroll
              for (int j = 0; j < 4; ++j) { const int n = (lane >> 3) + 8 * j; const LAS float* sq = scr + (8 * c) * 33 + n;
                  if (cur_i.fp8) { u32x2 o; o.x = pk4_fp8(sq[0 * 33] * SW8, sq[1 * 33] * SW8, sq[2 * 33] * SW8, sq[3 * 33] * SW8); o.y = pk4_fp8(sq[4 * 33] * SW8, sq[5 * 33] * SW8, sq[6 * 33] * SW8, sq[7 * 33] * SW8);
                      __builtin_nontemporal_store(o, (GAS u32x2*)(cur_i.dst + (size_t)(cur_i.drow0 + n) * DM + cur_i.k0 + 8 * c)); }
                  else { u32x4 o; o.x = cvt_pk_bf16(sq[0 * 33], sq[1 * 33]); o.y = cvt_pk_bf16(sq[2 * 33], sq[3 * 33]); o.z = cvt_pk_bf16(sq[4 * 33], sq[5 * 33]); o.w = cvt_pk_bf16(sq[6 * 33], sq[7 * 33]);
                      *(GAS u32x4*)((bf16*)cur_i.dst + (size_t)(cur_i.drow0 + n) * DM + cur_i.k0 + 8 * c) = o; } } }
            LDS_WAIT(); asm volatile("" ::: "memory");
            if (has_n) { cur_i = nxt_i;
#pragma unroll
                for (int i = 0; i < 8; ++i) tv[i] = tn[i]; }
        }
        {
            f32x4 g0v[4], b0v[4], cv[4], nv[4];
#pragma unroll
            for (int j = 0; j < 4; ++j) { g0v[j] = *((const GAS f32x4*)args.in[1] + lane + 64 * j); b0v[j] = *((const GAS f32x4*)args.in[2] + lane + 64 * j); }
            if (gw < NTOK) {
#pragma unroll
                for (int j = 0; j < 4; ++j) cv[j] = __builtin_nontemporal_load((const GAS f32x4*)(x_in + (size_t)gw * DM) + lane + 64 * j); }
            for (int m = gw; m < NTOK; m += NGW) {
                if (m + NGW < NTOK) {
#pragma unroll
                    for (int j = 0; j < 4; ++j) nv[j] = __builtin_nontemporal_load((const GAS f32x4*)(x_in + (size_t)(m + NGW) * DM) + lane + 64 * j); }
                float s = 0.f;
#pragma unroll
                for (int j = 0; j < 4; ++j) s += (cv[j].x + cv[j].y) + (cv[j].z + cv[j].w);
                const float mean = wave_sum(s) * (1.f / DM); float s2 = 0.f;
#pragma unroll
                for (int j = 0; j < 4; ++j) { cv[j] = cv[j] - mean; s2 += (cv[j].x * cv[j].x + cv[j].y * cv[j].y) + (cv[j].z * cv[j].z + cv[j].w * cv[j].w); }
                const float rstd = 1.f / sqrtf(wave_sum(s2) * (1.f / DM) + LN_EPS);
                GAS u32x2* o8 = (GAS u32x2*)(XN + (size_t)m * DM) + lane;
#pragma unroll
                for (int j = 0; j < 4; ++j) { const f32x4 y = cv[j] * rstd * g0v[j] + b0v[j]; u32x2 w; w.x = cvt_pk_bf16(y.x, y.y); w.y = cvt_pk_bf16(y.z, y.w); o8[64 * j] = w; }
#pragma unroll
                for (int j = 0; j < 4; ++j) cv[j] = nv[j];
            }
        }
        __syncthreads();
      }
        if (BOTH(0)) GRID_BAR();
    }

    if (IN(1)) {
        pg8::DenseOrder S; S.init(NTOK, IN_COLS, F.G, (int)blockIdx.x, Win_t);
        static_assert(WS_K - WS_Q == WS_V - WS_K && WS_HG - WS_V == WS_K - WS_Q, "Q|K|V|HG equally spaced");
        pg8::EpiIn E{Qb, (size_t)(WS_K - WS_Q) / 2};
        pg8::gemm_phase<pg8::EpiIn, pg8::DenseOrder>(F.lds + RING_OFF, (const char*)XN, S, E);
        if (NREP(1) == 2) { pg8::gemm_phase<pg8::EpiIn, pg8::DenseOrder>(F.lds + RING_OFF, (const char*)XN, S, E); }
        if (BOTH(1)) GRID_BAR();
    }

    if (IN(2)) {
        using namespace att;
      for (int rep_ = 0; rep_ < NREP(2); ++rep_) {
#ifndef NO_ATTN
        for (int rep8_ = 0; rep8_ < NREP(8); ++rep8_)
        for (int un = F.vcu; un < 256; un += F.G)
        for (int ui = 0; ui < 2; ++ui) {
            const int bh = un >> 3, jj = un & 7, j = ui == 0 ? 15 - jj : jj, b = bh >> 2, h = bh & 3;
            const int r32 = lane & 31, hi = lane >> 5;
            const int comp = wave >> 2, qi = wave & 3;
            const int p = 4 * j + qi;
            const int dt = p >> 1;
            const int T = 2 * j + 2;
            const size_t rowbase = (size_t)b * SEQ;
            const int q = 32 * p + r32;
            const float sl2 = LOG2E * (h == 0 ? 0.25f : h == 1 ? 0.0625f : h == 2 ? 0.015625f : 0.00390625f);
            bf16x8 qr[4];
            f32x16 o[4];
#pragma unroll
            for (int db = 0; db < 4; ++db)
#pragma unroll
                for (int r = 0; r < 16; ++r) o[db][r] = 0.f;
            float mrun = 0.f, lrun = 0.f;
            LAS float* wsf = (LAS float*)(F.lds + LDS_WS) + wave * 128;
            unsigned ksrc[2], vsrc[2];
#pragma unroll
            for (int i = 0; i < 2; ++i) { const int pc = 2 * wave + i;
                { const int kc = pc >> 3, krow = (pc & 7) * 8 + (lane >> 3), kch = (lane & 7) ^ ((krow >> 1) & 7);
                  ksrc[i] = (unsigned)((rowbase + krow) * AW + h * 128 + kc * 64 + kch * 8); }
                vsrc[i] = (unsigned)((rowbase + (pc & 3) * 16 + (lane >> 2)) * AW + h * 128 + (pc >> 2) * 32 + (lane & 3) * 8); }
            const unsigned ldsb = (unsigned)(size_t)(F.lds + RING_OFF) + (unsigned)(2 * wave) * 1024u;
#define ATT_ISSUE(t, st) do { _Pragma("unroll") for (int _i = 0; _i < 2; ++_i) { \
                glds16(Kb + ksrc[_i] + (size_t)(t) * 64 * AW, (unsigned)__builtin_amdgcn_readfirstlane(ldsb + (st) * STG + _i * 1024)); \
                glds16(Vb + vsrc[_i] + (size_t)(t) * 64 * AW, (unsigned)__builtin_amdgcn_readfirstlane(ldsb + (st) * STG + 16384 + _i * 1024)); } } while (0)
            const int vlane = ((lane >> 4) & 1) * 32 + (lane & 3) * 8 + (4 * hi + ((lane & 15) >> 2)) * 64;
            bf16x8 pa[4];
#pragma unroll
            for (int k = 0; k < 4; ++k) pa[k] = (bf16x8){0, 0, 0, 0, 0, 0, 0, 0};
            ATT_ISSUE(T - 1, 0);
            ATT_ISSUE(T - 2, 1);
            if (T > 2) ATT_ISSUE(T - 3, 2);
#pragma unroll
            for (int d0 = 0; d0 < 4; ++d0) qr[d0] = *(const bf16x8*)(Qb + (rowbase + 32 * p + r32) * AW + h * 128 + comp * 64 + d0 * 16 + hi * 8);
#pragma unroll
            for (int d0 = 0; d0 < 4; ++d0) asm volatile("" : "+v"(qr[d0]));
            asm volatile("s_waitcnt vmcnt(0)" ::: "memory");
            asm volatile("s_waitcnt lgkmcnt(0)\n\ts_barrier" ::: "memory");
            if (comp == 1) asm volatile("s_barrier" ::: "memory");
            for (int it = 0; it < T; ++it) {
                const int t = T - 1 - it;
                const int sc = it & 3, sprev = it == 0 ? 0 : (it - 1) & 3;
                if (comp == 0 && it >= 1 && it + 2 < T) ATT_ISSUE(t - 2, (it + 2) & 3);
                f32x16 p0, p1;
                {
                    const LAS unsigned char* Ks = F.lds + RING_OFF + sc * STG;
                    const LAS unsigned char* Vs = F.lds + RING_OFF + sprev * STG + 16384;
                    bf16x8 kf[8]; s16x4 vA[16], vB[16];
#pragma unroll
                    for (int d0 = 0; d0 < 4; ++d0) { const LAS unsigned char* kb = Ks + comp * 8192 + (r32 >> 3) * 1024 + (r32 & 7) * 128 + (((2 * d0 + hi) ^ ((r32 >> 1) & 7)) * 16);
                        kf[2 * d0] = *(const LAS bf16x8*)kb; kf[2 * d0 + 1] = *(const LAS bf16x8*)(kb + 4096); }
#pragma unroll
                    for (int i = 0; i < 8; ++i) { const LAS unsigned char* vp = Vs + i * 1024 + vlane; vA[2 * i] = vtr(vp); vA[2 * i + 1] = vtr(vp + 512); }
                    float sl2v = sl2; asm volatile("" : "+v"(sl2v));
                    const float fb = sl2v * (float)(64 * t + 4 * hi - q) - mrun;
#pragma unroll
                    for (int r = 0; r < 16; ++r) { p0[r] = fb + sl2v * (float)((r & 3) + 8 * (r >> 2)); p1[r] = p0[r] + 32.0f * sl2v; }
                    __builtin_amdgcn_sched_barrier(0);
#pragma unroll
                    for (int d0 = 0; d0 < 4; ++d0) {
                        p0 = __builtin_amdgcn_mfma_f32_32x32x16_bf16(kf[2 * d0], qr[d0], p0, 0, 0, 0);
                        p1 = __builtin_amdgcn_mfma_f32_32x32x16_bf16(kf[2 * d0 + 1], qr[d0], p1, 0, 0, 0);
                    }
                    __builtin_amdgcn_sched_barrier(0);
#pragma unroll
                    for (int i = 0; i < 8; ++i) { const LAS unsigned char* vp = Vs + (8 + i) * 1024 + vlane; vB[2 * i] = vtr(vp); vB[2 * i + 1] = vtr(vp + 512); }
#pragma unroll
                    for (int db = 0; db < 2; ++db)
#pragma unroll
                        for (int ks = 0; ks < 4; ++ks) { const int i = db * 4 + ks; const s16x4 vl = vA[2 * i], vh = vA[2 * i + 1];
                            o[db] = __builtin_amdgcn_mfma_f32_32x32x16_bf16(pa[ks], (bf16x8){vl[0], vl[1], vl[2], vl[3], vh[0], vh[1], vh[2], vh[3]}, o[db], 0, 0, 0); }
                    __builtin_amdgcn_sched_barrier(0);
#pragma unroll
                    for (int db = 2; db < 4; ++db)
#pragma unroll
                        for (int ks = 0; ks < 4; ++ks) { const int i = (db - 2) * 4 + ks; const s16x4 vl = vB[2 * i], vh = vB[2 * i + 1];
                            o[db] = __builtin_amdgcn_mfma_f32_32x32x16_bf16(pa[ks], (bf16x8){vl[0], vl[1], vl[2], vl[3], vh[0], vh[1], vh[2], vh[3]}, o[db], 0, 0, 0); }
                    __builtin_amdgcn_sched_barrier(0);
                }
                if (comp == 1) { if (it + 2 < T) asm volatile("s_waitcnt vmcnt(4)" ::: "memory"); else asm volatile("s_waitcnt vmcnt(0)" ::: "memory"); }
                asm volatile("s_waitcnt lgkmcnt(0)\n\ts_barrier" ::: "memory");
                if (comp == 1 && it + 3 < T) ATT_ISSUE(t - 3, (it + 3) & 3);
                {
                    if (t >= dt) {
                        const int kb0 = 64 * t + 4 * hi - q;
#pragma unroll
                        for (int r = 0; r < 16; ++r) { const int rel = kb0 + (r & 3) + 8 * (r >> 2); if (rel > 0) p0[r] = -INFINITY; if (rel + 32 > 0) p1[r] = -INFINITY; }
                    }
                    float rm = __builtin_fmaxf(__builtin_fmaxf(p0[0], p0[1]), p1[0]), rm2 = __builtin_fmaxf(__builtin_fmaxf(p0[2], p0[3]), p1[1]);
                    rm = __builtin_fmaxf(__builtin_fmaxf(rm, p1[2]), p1[3]);
#pragma unroll
                    for (int r = 4; r < 16; r += 4) { rm = __builtin_fmaxf(__builtin_fmaxf(rm, p0[r]), p0[r + 1]); rm2 = __builtin_fmaxf(__builtin_fmaxf(rm2, p0[r + 2]), p0[r + 3]);
                        rm = __builtin_fmaxf(__builtin_fmaxf(rm, p1[r]), p1[r + 1]); rm2 = __builtin_fmaxf(__builtin_fmaxf(rm2, p1[r + 2]), p1[r + 3]); }
                    rm = swapmax(__builtin_fmaxf(rm, rm2));
                    if (__any(rm > 8.0f)) {
                        const float dl = __builtin_fmaxf(rm, 0.f), f = fast_exp2(-dl);
                        lrun *= f; mrun += dl;
#pragma unroll
                        for (int r = 0; r < 16; ++r) { p0[r] -= dl; p1[r] -= dl; }
                        if (hi == 0) wsf[r32] = f;
                        LDS_WAIT();
#pragma unroll
                        for (int r = 0; r < 16; ++r) { const float fr_ = wsf[crow(r, hi)];
#pragma unroll
                            for (int db = 0; db < 4; ++db) o[db][r] *= fr_; }
                        LDS_WAIT();
                    }
                    float ls = 0.f;
#pragma unroll
                    for (int r = 0; r < 16; ++r) { p0[r] = fast_exp2(p0[r]); p1[r] = fast_exp2(p1[r]); ls += p0[r] + p1[r]; }
                    lrun += ls;
                    u32x4 w0, w1, w2, w3;
                    w0.x = cvt_pk_bf16(p0[0], p0[1]); w0.y = cvt_pk_bf16(p0[2], p0[3]); w0.z = cvt_pk_bf16(p0[4], p0[5]); w0.w = cvt_pk_bf16(p0[6], p0[7]);
                    w1.x = cvt_pk_bf16(p0[8], p0[9]); w1.y = cvt_pk_bf16(p0[10], p0[11]); w1.z = cvt_pk_bf16(p0[12], p0[13]); w1.w = cvt_pk_bf16(p0[14], p0[15]);
                    w2.x = cvt_pk_bf16(p1[0], p1[1]); w2.y = cvt_pk_bf16(p1[2], p1[3]); w2.z = cvt_pk_bf16(p1[4], p1[5]); w2.w = cvt_pk_bf16(p1[6], p1[7]);
                    w3.x = cvt_pk_bf16(p1[8], p1[9]); w3.y = cvt_pk_bf16(p1[10], p1[11]); w3.z = cvt_pk_bf16(p1[12], p1[13]); w3.w = cvt_pk_bf16(p1[14], p1[15]);
                    pa[0] = __builtin_bit_cast(bf16x8, w0); pa[1] = __builtin_bit_cast(bf16x8, w1); pa[2] = __builtin_bit_cast(bf16x8, w2); pa[3] = __builtin_bit_cast(bf16x8, w3);
                }
                if (comp == 0) { if (it + 2 < T) asm volatile("s_waitcnt vmcnt(4)" ::: "memory"); else asm volatile("s_waitcnt vmcnt(0)" ::: "memory"); }
                asm volatile("s_waitcnt lgkmcnt(0)\n\ts_barrier" ::: "memory");
            }
            {
                const LAS unsigned char* Vs = F.lds + RING_OFF + ((T - 1) & 3) * STG + 16384;
#pragma unroll
                for (int db = 0; db < 4; ++db)
#pragma unroll
                    for (int ks = 0; ks < 4; ++ks) { const LAS unsigned char* vp = Vs + (db * 4 + ks) * 1024 + vlane; const s16x4 vl = vtr(vp), vh = vtr(vp + 512);
                        o[db] = __builtin_amdgcn_mfma_f32_32x32x16_bf16(pa[ks], (bf16x8){vl[0], vl[1], vl[2], vl[3], vh[0], vh[1], vh[2], vh[3]}, o[db], 0, 0, 0); }
            }
            if (comp == 0) asm volatile("s_barrier" ::: "memory");
#undef ATT_ISSUE
            asm volatile("s_waitcnt lgkmcnt(0)\n\ts_barrier" ::: "memory");
            {
                int lane_o = lane; asm volatile("" : "+v"(lane_o));
                const int r32o = lane_o & 31, hio = lane_o >> 5;
                LAS float* wsf2 = (LAS float*)(F.lds + LDS_WS) + wave * 128;
                LAS float* XB = (LAS float*)(F.lds + RING_OFF) + qi * 4096 + lane_o;
                const float linv = fast_rcp(swapsum(lrun));
                if (comp == 1) {
                    float lam;
                    { const float a = args.in[4][lane_o] * args.in[5][lane_o], bb2 = args.in[6][lane_o] * args.in[7][lane_o];
                      lam = __expf(wave_sum(a)) - __expf(wave_sum(bb2)) + LAMBDA_INIT; }
                    if (hio == 0) wsf2[r32o] = lam * linv;
                    LDS_WAIT();
#pragma unroll
                    for (int r = 0; r < 16; ++r) { const float a1 = wsf2[crow(r, hio)];
#pragma unroll
                        for (int db = 0; db < 4; ++db) XB[(db * 16 + r) * 64] = o[db][r] * a1; }
                }
                asm volatile("s_waitcnt lgkmcnt(0)\n\ts_barrier" ::: "memory");
                if (comp == 0) {
                    if (hio == 0) wsf2[r32o] = linv;
                    LDS_WAIT();
                    float gsub[4];
#pragma unroll
                    for (int db = 0; db < 4; ++db) gsub[db] = args.in[8][db * 32 + r32o] * (1.0f - LAMBDA_INIT);
#pragma unroll
                    for (int r = 0; r < 16; ++r) {
                        const int qq = crow(r, hio); const float a0 = wsf2[qq];
                        float v[4], ss = 0.f;
#pragma unroll
                        for (int db = 0; db < 4; ++db) { v[db] = o[db][r] * a0 - XB[(db * 16 + r) * 64]; ss += v[db] * v[db]; }
                        ss += __shfl_xor(ss, 1); ss += __shfl_xor(ss, 2); ss += __shfl_xor(ss, 4); ss += __shfl_xor(ss, 8); ss += __shfl_xor(ss, 16);
                        const float rs = 1.0f / sqrtf(ss * (1.0f / 128.0f) + LN_EPS);
                        bf16* op = AC + (rowbase + 32 * p + qq) * DM + h * 128 + r32o;
#pragma unroll
                        for (int db = 0; db < 4; ++db) op[db * 32] = (bf16)(cvt_pk_bf16(v[db] * rs * gsub[db], 0.f) & 0xffffu);
                    }
                }
            }
            asm volatile("s_waitcnt lgkmcnt(0)\n\ts_barrier" ::: "memory");
        }
#endif
#ifndef NO_CONV
        {
            LAS float* WP = (LAS float*)(F.lds + RING_OFF);
            for (int idx = tid; idx < 47 * 512; idx += NWAVES * 64) { const int jj = idx >> 9, ch = idx & 511, j = jj - 7; WP[idx] = (j >= 0 && j <= 30) ? args.in[9][j * 512 + ch] : 0.f; }
            __syncthreads();
            const int ch0 = lane * 8;
            for (int rep9_ = 0; rep9_ < NREP(9); ++rep9_)
            for (int item = gw; item < NTOK / 8; item += NGW) {
                const int t0 = item * 8, tpos = t0 & (SEQ - 1);
                float acc[8][8];
                { const f32x4 b0 = *(const f32x4*)(args.in[10] + ch0), b1 = *(const f32x4*)(args.in[10] + ch0 + 4);
#pragma unroll
                  for (int tt = 0; tt < 8; ++tt) { acc[tt][0] = b0[0]; acc[tt][1] = b0[1]; acc[tt][2] = b0[2]; acc[tt][3] = b0[3]; acc[tt][4] = b1[0]; acc[tt][5] = b1[1]; acc[tt][6] = b1[2]; acc[tt][7] = b1[3]; } }
                u32x4 cur[4], nxt[4];
                const bf16* hg0 = HG + (size_t)t0 * AW + ch0;
#pragma unroll
                for (int ii = 0; ii < 4; ++ii) { const bool ok_ = (tpos - 30 + ii >= 0); const u32x4 v_ = *(const u32x4*)(hg0 + (ok_ ? (ii - 30) * AW : 0)); cur[ii] = ok_ ? v_ : (u32x4){0u, 0u, 0u, 0u}; }
#pragma unroll 1
                for (int ck = 0; ck < 10; ++ck) {
#pragma unroll
                    for (int ii = 0; ii < 4; ++ii) { const int i_ = (ck + 1) * 4 + ii; const bool ok_ = (i_ < 38) && (tpos - 30 + i_ >= 0); const u32x4 v_ = *(const u32x4*)(hg0 + (ok_ ? (i_ - 30) * AW : 0)); nxt[ii] = ok_ ? v_ : (u32x4){0u, 0u, 0u, 0u}; }
                    const LAS float* wck = WP + ck * 4 * 512 + ch0;
#pragma unroll
                    for (int ii = 0; ii < 4; ++ii) {
                        const u32x4 hw = cur[ii];
                        float hv[8]; hv[0] = bf_lo(hw.x); hv[1] = bf_hi(hw.x); hv[2] = bf_lo(hw.y); hv[3] = bf_hi(hw.y); hv[4] = bf_lo(hw.z); hv[5] = bf_hi(hw.z); hv[6] = bf_lo(hw.w); hv[7] = bf_hi(hw.w);
                        const LAS float* wr_ = wck + ii * 512;
#pragma unroll
                        for (int tt = 0; tt < 8; ++tt) { const f32x4 w0 = *(const LAS f32x4*)(wr_ + (7 - tt) * 512), w1 = *(const LAS f32x4*)(wr_ + (7 - tt) * 512 + 4);
                            acc[tt][0] += w0[0] * hv[0]; acc[tt][1] += w0[1] * hv[1]; acc[tt][2] += w0[2] * hv[2]; acc[tt][3] += w0[3] * hv[3];
                            acc[tt][4] += w1[0] * hv[4]; acc[tt][5] += w1[1] * hv[5]; acc[tt][6] += w1[2] * hv[6]; acc[tt][7] += w1[3] * hv[7]; }
                    }
#pragma unroll
                    for (int ii = 0; ii < 4; ++ii) cur[ii] = nxt[ii];
                }
                const f32x4 g0 = *(const f32x4*)(args.in[11] + ch0), g1 = *(const f32x4*)(args.in[11] + ch0 + 4), c0 = *(const f32x4*)(args.in[12] + ch0), c1 = *(const f32x4*)(args.in[12] + ch0 + 4);
#pragma unroll
                for (int tt = 0; tt < 8; ++tt) {
                    float s = 0.f;
#pragma unroll
                    for (int k = 0; k < 8; ++k) s += acc[tt][k];
                    const float mean = wave_sum(s) * (1.0f / 512.0f); float s2 = 0.f;
#pragma unroll
                    for (int k = 0; k < 8; ++k) { acc[tt][k] -= mean; s2 += acc[tt][k] * acc[tt][k]; }
                    const float rstd = 1.0f / sqrtf(wave_sum(s2) * (1.0f / 512.0f) + LN_EPS);
                    float y[8];
#pragma unroll
                    for (int k = 0; k < 8; ++k) { const float gg = k < 4 ? g0[k & 3] : g1[k & 3], cc = k < 4 ? c0[k & 3] : c1[k & 3]; const float v = acc[tt][k] * rstd * gg + cc; y[k] = v * sigmoidf_(v); }
                    u32x4 w; w.x = cvt_pk_bf16(y[0], y[1]); w.y = cvt_pk_bf16(y[2], y[3]); w.z = cvt_pk_bf16(y[4], y[5]); w.w = cvt_pk_bf16(y[6], y[7]);
                    *(u32x4*)(AC + (size_t)(t0 + tt) * DM + 512 + ch0) = w;
                }
            }
            __syncthreads();
        }
#endif
      }
        if (BOTH(2)) GRID_BAR();
    }

    if (IN(3)) {
        pg8::DenseOrder S; S.init(NTOK, DM, F.G, (int)blockIdx.x, Wout_t);
        pg8::EpiOut E{Y1, XN};
        pg8::gemm_phase<pg8::EpiOut, pg8::DenseOrder>(F.lds + RING_OFF, (const char*)AC, S, E);
        if (NREP(3) == 2) { pg8::gemm_phase<pg8::EpiOut, pg8::DenseOrder>(F.lds + RING_OFF, (const char*)AC, S, E); }
        if (BOTH(3)) GRID_BAR();
    }

    if (IN(4)) {
        constexpr int XSTR = 1028;
        LAS float* XS = (LAS float*)(F.lds + RING_OFF);
        LAS float* PL = (LAS float*)(F.lds + RING_OFF + 65792);
        LAS float* LG = (LAS float*)(F.lds + RING_OFF + 82176);
        LAS int* SEL = (LAS int*)(F.lds + RING_OFF + 84224);
        LAS float* GT = (LAS float*)(F.lds + RING_OFF + 85248);
        LAS int* RK = (LAS int*)(F.lds + RING_OFF + 86272);
        LAS int* LCNT = (LAS int*)(F.lds + RING_OFF + 87296);
        LAS int* GBASE = (LAS int*)(F.lds + RING_OFF + 87424);
        if (tid < 32) LCNT[tid] = 0;
        float rwf[32][2];
#pragma unroll
        for (int s = 0; s < 32; ++s) { const int k = 128 * wave + 4 * s + (lane >> 4); rwf[s][0] = args.in[16][k * 32 + (lane & 15)]; rwf[s][1] = args.in[16][k * 32 + 16 + (lane & 15)]; }
        __syncthreads();
        int gi = 0;
        for (int rep10_ = 0; rep10_ < NREP(10); ++rep10_) {
        if (rep10_ == 1) { __syncthreads(); if (tid < 32) LCNT[tid] = 0; __syncthreads(); }
        gi = 0;
        f32x4 g1v[4], b1v[4];
#pragma unroll
        for (int j = 0; j < 4; ++j) { g1v[j] = *((const GAS f32x4*)args.in[14] + lane + 64 * j); b1v[j] = *((const GAS f32x4*)args.in[15] + lane + 64 * j); }
        f32x4 cvr[2][4], nvr[2][4];
        if ((int)blockIdx.x < NTOK / 16) {
#pragma unroll
            for (int rr = 0; rr < 2; ++rr)
#pragma unroll
                for (int j = 0; j < 4; ++j) cvr[rr][j] = __builtin_nontemporal_load((const GAS f32x4*)(Y1 + ((size_t)blockIdx.x * 16 + 2 * wave + rr) * DM) + lane + 64 * j); }
        for (int g = blockIdx.x; g < NTOK / 16; g += F.G, ++gi) {
            if (g + F.G < NTOK / 16) {
#pragma unroll
                for (int rr = 0; rr < 2; ++rr)
#pragma unroll
                    for (int j = 0; j < 4; ++j) nvr[rr][j] = __builtin_nontemporal_load((const GAS f32x4*)(Y1 + ((size_t)(g + F.G) * 16 + 2 * wave + rr) * DM) + lane + 64 * j); }
#pragma unroll
            for (int rr = 0; rr < 2; ++rr) {
                const int lr = 2 * wave + rr; const size_t row = (size_t)g * 16 + lr;
                f32x4 v[4]; float s = 0.f;
#pragma unroll
                for (int j = 0; j < 4; ++j) { v[j] = cvr[rr][j]; s += (v[j].x + v[j].y) + (v[j].z + v[j].w); }
                const float mean = wave_sum(s) * (1.f / DM); float s2 = 0.f;
#pragma unroll
                for (int j = 0; j < 4; ++j) { v[j] = v[j] - mean; s2 += (v[j].x * v[j].x + v[j].y * v[j].y) + (v[j].z * v[j].z + v[j].w * v[j].w); }
                const float rstd = 1.f / sqrtf(wave_sum(s2) * (1.f / DM) + LN_EPS);
                GAS u32x2* o8 = (GAS u32x2*)(X1 + row * DM) + lane;
#pragma unroll
                for (int j = 0; j < 4; ++j) { const f32x4 y = v[j] * rstd * g1v[j] + b1v[j]; u32x2 w; w.x = cvt_pk_bf16(y.x, y.y); w.y = cvt_pk_bf16(y.z, y.w); o8[64 * j] = w;
                    *((GAS unsigned*)(X1Q + row * DM) + lane + 64 * j) = pk4_fp8(y.x * SX8, y.y * SX8, y.z * SX8, y.w * SX8);
                    *(LAS f32x4*)(XS + lr * XSTR + 4 * lane + 256 * j) = y; }
#pragma unroll
                for (int j = 0; j < 4; ++j) cvr[rr][j] = nvr[rr][j];
            }
            __syncthreads();
            {
                f32x4 a0 = (f32x4){0.f, 0.f, 0.f, 0.f}, a1 = a0;
                const LAS float* xp = XS + (lane & 15) * XSTR + 128 * wave + (lane >> 4);
#pragma unroll
                for (int s = 0; s < 32; ++s) { const float a = xp[4 * s];
                    a0 = __builtin_amdgcn_mfma_f32_16x16x4f32(a, rwf[s][0], a0, 0, 0, 0);
                    a1 = __builtin_amdgcn_mfma_f32_16x16x4f32(a, rwf[s][1], a1, 0, 0, 0); }
#pragma unroll
                for (int r = 0; r < 4; ++r) { PL[(wave * 16 + 4 * (lane >> 4) + r) * 32 + (lane & 15)] = a0[r]; PL[(wave * 16 + 4 * (lane >> 4) + r) * 32 + 16 + (lane & 15)] = a1[r]; }
            }
            __syncthreads();
            {
                const int row = 2 * wave + (lane >> 5), e = lane & 31; float lg = args.in[17][e];
#pragma unroll
                for (int w = 0; w < 8; ++w) lg += PL[(w * 16 + row) * 32 + e];
                int se[4]; float sv[4];
#pragma unroll
                for (int k = 0; k < 4; ++k) { float bv = lg; int bi = e;
#pragma unroll
                    for (int off = 16; off >= 1; off >>= 1) { const float ov = __shfl_xor(bv, off); const int oi = __shfl_xor(bi, off); const bool take = (ov > bv) || (ov == bv && oi < bi); bv = take ? ov : bv; bi = take ? oi : bi; }
                    se[k] = bi; sv[k] = bv; if (e == bi) lg = -INFINITY; }
                float ex[4], es = 0.f;
#pragma unroll
                for (int k = 0; k < 4; ++k) { ex[k] = __expf(sv[k] - sv[0]); es += ex[k]; }
                const float inv = 1.0f / es; const int lrow = gi * 16 + row;
                if (e < 4) { const int ek = e == 0 ? se[0] : (e == 1 ? se[1] : (e == 2 ? se[2] : se[3])); const float gk = (e == 0 ? ex[0] : (e == 1 ? ex[1] : (e == 2 ? ex[2] : ex[3]))) * inv;
                    SEL[lrow * 4 + e] = ek; GT[lrow * 4 + e] = gk; RK[lrow * 4 + e] = atomicAdd((int*)&LCNT[ek], 1); }
            }
        }
        }
        __syncthreads();
        if (tid < 32) GBASE[tid] = (int)__hip_atomic_fetch_add(F.ctl + CW_GCNT + 64 * tid, (unsigned)LCNT[tid], RLX_AGENT);
        __syncthreads();
        if (tid < 256) {
            const int lrow = tid >> 2, k = tid & 3, gidx = lrow >> 4;
            if (gidx < gi) { const int g = blockIdx.x + gidx * F.G, token = g * 16 + (lrow & 15), p = token * 4 + k, e = SEL[lrow * 4 + k];
                const int pos = GBASE[e] + RK[lrow * 4 + k]; LIST[e * LISTCAP + pos] = p; GATEW[e * LISTCAP + pos] = GT[lrow * 4 + k]; }
        }
        __syncthreads();
        if (BOTH(4)) GRID_BAR();
    }

    if (IN(5) || IN(6)) {
        LAS int* TP = (LAS int*)(F.lds + MOE_TP_OFF); LAS int* CN = TP + 64;
        if (tid < 32) CN[tid] = (int)__hip_atomic_load(F.ctl + CW_GCNT + 64 * tid, RLX_AGENT);
        __syncthreads();
        if (tid == 0) { int a = 0; for (int e = 0; e < 32; ++e) { TP[e] = a; a += (CN[e] + 255) >> 8; } TP[32] = a; }
        __syncthreads();
    }
    if (IN(5)) {
        pg8::MoeOrder<8, true, 1024> S{(const LAS int*)(F.lds + MOE_TP_OFF), (const LAS int*)(F.lds + MOE_TP_OFF) + 64, F.G, F.vcu, lane, LIST, (const char*)Wgu_t, (size_t)2048 * DM, GATEW, args.in[19], (unsigned)(size_t)(F.lds + MOE_STG_OFF)};
        pg8::EpiSwiglu E{HID, args.in[19]};
        pg8::gemm_phase<pg8::EpiSwiglu, pg8::MoeOrder<8, true, 1024>, true>(F.lds + RING_OFF, (const char*)X1Q, S, E);
        if (NREP(5) == 2) { pg8::gemm_phase<pg8::EpiSwiglu, pg8::MoeOrder<8, true, 1024>, true>(F.lds + RING_OFF, (const char*)X1Q, S, E); }
        if (BOTH(5)) GRID_BAR();
    }
    if (IN(6)) {
        pg8::MoeOrder<4, false, 1024> S{(const LAS int*)(F.lds + MOE_TP_OFF), (const LAS int*)(F.lds + MOE_TP_OFF) + 64, F.G, F.vcu, lane, LIST, (const char*)Wd_t, (size_t)DM * DFF, GATEW, args.in[21], (unsigned)(size_t)(F.lds + MOE_STG_OFF)};
        pg8::EpiDown E{YP, args.in[21], LIST, GATEW};
        pg8::gemm_phase<pg8::EpiDown, pg8::MoeOrder<4, false, 1024>, true>(F.lds + RING_OFF, (const char*)HID, S, E);
        if (NREP(6) == 2) { pg8::gemm_phase<pg8::EpiDown, pg8::MoeOrder<4, false, 1024>, true>(F.lds + RING_OFF, (const char*)HID, S, E); }
        if (BOTH(6)) GRID_BAR();
    }
    if (IN(7)) {
        const unsigned bad = (MK_N_LAUNCHES == 1) ? __hip_atomic_load((gu32*)(F.ctl + CW_BAR + XB_TMO), RLX_AGENT) : 0u;
        f32x4 g2v[4], b2v[4];
#pragma unroll
        for (int j = 0; j < 2; ++j)
#pragma unroll
            for (int hh = 0; hh < 2; ++hh) { const int c0 = 8 * lane + 512 * j + 4 * hh; g2v[2 * j + hh] = *(const f32x4*)(args.in[22] + c0); b2v[2 * j + hh] = *(const f32x4*)(args.in[23] + c0); }
        for (int rep_ = 0; rep_ < NREP(7); ++rep_) {
        u32x4 cx[2], cy[8], nx[2], ny[8];
#define P7_LOAD(dx, dy, r_) do { _Pragma("unroll") for (int j = 0; j < 2; ++j) dx[j] = __builtin_nontemporal_load((const u32x4*)(X1 + (size_t)(r_) * DM + 8 * lane + 512 * j)); \
            _Pragma("unroll") for (int k = 0; k < 4; ++k) _Pragma("unroll") for (int j = 0; j < 2; ++j) dy[2 * k + j] = __builtin_nontemporal_load((const u32x4*)(YP + ((size_t)(r_) * 4 + k) * DM + 8 * lane + 512 * j)); } while (0)
        if (gw < NTOK) P7_LOAD(cx, cy, gw);
        for (int row = gw; row < NTOK; row += NGW) {
            if (row + NGW < NTOK) P7_LOAD(nx, ny, row + NGW);
            float v[16];
#pragma unroll
            for (int j = 0; j < 2; ++j) { const u32x4 xw = cx[j];
                v[8 * j + 0] = ALPHA * bf_lo(xw.x); v[8 * j + 1] = ALPHA * bf_hi(xw.x); v[8 * j + 2] = ALPHA * bf_lo(xw.y); v[8 * j + 3] = ALPHA * bf_hi(xw.y);
                v[8 * j + 4] = ALPHA * bf_lo(xw.z); v[8 * j + 5] = ALPHA * bf_hi(xw.z); v[8 * j + 6] = ALPHA * bf_lo(xw.w); v[8 * j + 7] = ALPHA * bf_hi(xw.w); }
#pragma unroll
            for (int k = 0; k < 4; ++k)
#pragma unroll
                for (int j = 0; j < 2; ++j) { const u32x4 yw = cy[2 * k + j];
                    v[8 * j + 0] += bf_lo(yw.x); v[8 * j + 1] += bf_hi(yw.x); v[8 * j + 2] += bf_lo(yw.y); v[8 * j + 3] += bf_hi(yw.y);
                    v[8 * j + 4] += bf_lo(yw.z); v[8 * j + 5] += bf_hi(yw.z); v[8 * j + 6] += bf_lo(yw.w); v[8 * j + 7] += bf_hi(yw.w); }
            float s = 0.f;
#pragma unroll
            for (int i = 0; i < 16; ++i) s += v[i];
            const float mean = wave_sum(s) * (1.f / DM); float s2 = 0.f;
#pragma unroll
            for (int i = 0; i < 16; ++i) { v[i] -= mean; s2 += v[i] * v[i]; }
            const float rstd = 1.f / sqrtf(wave_sum(s2) * (1.f / DM) + LN_EPS);
#pragma unroll
            for (int j = 0; j < 2; ++j)
#pragma unroll
                for (int hh = 0; hh < 2; ++hh) { const int c0 = 8 * lane + 512 * j + 4 * hh; const f32x4 gg = g2v[2 * j + hh], bb = b2v[2 * j + hh];
                    f32x4 o; o[0] = v[8 * j + 4 * hh + 0] * rstd * gg[0] + bb[0]; o[1] = v[8 * j + 4 * hh + 1] * rstd * gg[1] + bb[1]; o[2] = v[8 * j + 4 * hh + 2] * rstd * gg[2] + bb[2]; o[3] = v[8 * j + 4 * hh + 3] * rstd * gg[3] + bb[3];
                    if (bad) { const float qn = __builtin_nanf(""); o = (f32x4){qn, qn, qn, qn}; }
                    __builtin_nontemporal_store(o, (f32x4*)(args.out + (size_t)row * DM + c0)); }
#pragma unroll
            for (int j = 0; j < 2; ++j) cx[j] = nx[j];
#pragma unroll
            for (int k = 0; k < 8; ++k) cy[k] = ny[k];
        }
#undef P7_LOAD
        }
    }
#undef IN
#undef BOTH
#undef GRID_BAR
}

extern "C" void kernel_launch(void* const* d_in, const int* in_sizes, int n_in, void* d_out, int out_size, void* d_ws, size_t ws_size, hipStream_t stream) {
    static int grid = 0;
    if (grid == 0) {
        if (n_in != 24 || in_sizes[0] != NTOK * DM || out_size != NTOK * DM || ws_size < WS_END) { fprintf(stderr, "kernel_launch: unexpected shapes (n_in %d, in0 %d, out %d, ws %zu); nothing launched\n", n_in, n_in > 0 ? in_sizes[0] : -1, out_size, ws_size); grid = -1; return; }
        int dev = 0, cus = 0, per_cu = 0;
        if (hipGetDevice(&dev) != hipSuccess || hipDeviceGetAttribute(&cus, hipDeviceAttributeMultiprocessorCount, dev) != hipSuccess) { grid = -1; return; }
        if (hipFuncSetAttribute((const void*)hymba_fwd, hipFuncAttributeMaxDynamicSharedMemorySize, LDS_BYTES) != hipSuccess) { fprintf(stderr, "kernel_launch: hipFuncSetAttribute failed\n"); grid = -1; return; }
        if (hipOccupancyMaxActiveBlocksPerMultiprocessor(&per_cu, (const void*)hymba_fwd, NWAVES * 64, LDS_BYTES) != hipSuccess || per_cu < 1)
            fprintf(stderr, "kernel_launch: note: occupancy query reports %d workgroups per CU\n", per_cu);
        (void)hipGetLastError();
        grid = cus;
        if (grid != 256) fprintf(stderr, "kernel_launch: %d CUs; this kernel is laid out for 256\n", grid);
    }
    if (grid < 0) return;
    (void)hipMemsetAsync((char*)d_ws + WS_CTL, 0, CTL_ZERO_BYTES, stream);
    Args a{};
    for (int i = 0; i < 24; ++i) a.in[i] = (const float*)d_in[i];
    a.out = (float*)d_out; a.ws = (unsigned char*)d_ws;
    if (MK_N_LAUNCHES == 1) { a.ph_lo = 0; a.ph_hi = 8; hipLaunchKernelGGL(hymba_fwd, dim3(grid), dim3(NWAVES * 64), LDS_BYTES, stream, a); }
    else for (int li = 0; li < 8; ++li) { a.ph_lo = li; a.ph_hi = li + 1; hipLaunchKernelGGL(hymba_fwd, dim3(grid), dim3(NWAVES * 64), LDS_BYTES, stream, a); }
}
```
